# Optimizing an MI355X kernel written in HIP

```python
import math
import jax, jax.numpy as jnp
from jax import lax
import numpy as np

D_MODEL = 2048
BATCH = 4
SEQ = 2048
DEPTH = 4
DEC_BATCH = 128
DEC_SEQ = 1
PAST_LEN = 16384
PAGE_SIZE = 128

N_MIXERS = 2
POOL_WINDOWS = (2, 4, 8, 16)
N_POOL_GROUPS = len(POOL_WINDOWS)
POOL_GROUP = D_MODEL // N_POOL_GROUPS
POOL_CTX = max(POOL_WINDOWS) - 1
GLA_HEADS = 4
GLA_KEY_DIM = D_MODEL // 2
GLA_VAL_DIM = D_MODEL
GLA_DK = GLA_KEY_DIM // GLA_HEADS
GLA_DV = GLA_VAL_DIM // GLA_HEADS
GLA_GATE_RANK = 16
GLA_GATE_TEMP = 16.0
GLA_CHUNK = 16
GLA_IN = 2 * GLA_KEY_DIM + 2 * GLA_VAL_DIM + GLA_GATE_RANK
D_FF = 4 * D_MODEL
LN_EPS = 1e-5
RMS_EPS = 1e-5
DN_ALPHA = (2 * DEPTH) ** 0.25
DN_BETA = (8 * DEPTH) ** -0.25
N_POOL_LAYERS = (DEPTH + 1) // 2
N_GLA_LAYERS = DEPTH // 2

kernel_name = "hybrid_pool_gla_deepnorm_step"


def layer_norm(x, g, b):
    xf = x.astype(jnp.float32)
    mu = jnp.mean(xf, axis=-1, keepdims=True)
    var = jnp.mean(jnp.square(xf - mu), axis=-1, keepdims=True)
    y = (xf - mu) * lax.rsqrt(var + LN_EPS) * g.astype(jnp.float32) + b.astype(jnp.float32)
    return y.astype(x.dtype)


def pool_mixer(x_ctx, x, pos0, w_groups, scale):
    n_ctx = x_ctx.shape[1]
    L = x.shape[1]
    xe = jnp.concatenate([x_ctx, x.astype(x_ctx.dtype)], axis=1)
    cs = jnp.cumsum(xe.astype(jnp.float32), axis=1)
    pos = pos0 + n_ctx + jnp.arange(L, dtype=jnp.int32)
    xf = x.astype(jnp.float32)
    outs = []
    for g, w in enumerate(POOL_WINDOWS):
        sl = slice(g * POOL_GROUP, (g + 1) * POOL_GROUP)
        csp = jnp.pad(cs[..., sl], ((0, 0), (w, 0), (0, 0)))
        win = csp[:, n_ctx + w:] - csp[:, n_ctx:n_ctx + L]
        count = jnp.minimum(pos + 1, w).astype(jnp.float32)[None, :, None]
        p = win / count - xf[..., sl]
        outs.append(jnp.einsum('blc,cd->bld', p, w_groups[g].astype(jnp.float32)))
    y = jnp.concatenate(outs, axis=-1) * scale.astype(jnp.float32)
    new_state = xe[:, -POOL_CTX:]
    return y.astype(x.dtype), new_state


def gla_mixer(x, s0, w_in, w_gate_up, gate_bias, norm_w, w_out):
    B, L, _ = x.shape
    K, V = GLA_KEY_DIM, GLA_VAL_DIM
    proj = jnp.einsum('bld,de->ble', x, w_in)
    q, k, v, og, gk_low = jnp.split(proj, [K, 2 * K, 2 * K + V, 2 * K + 2 * V], axis=-1)
    gk = jnp.einsum('blr,rk->blk', gk_low, w_gate_up) + gate_bias
    log_a = jax.nn.log_sigmoid(gk.astype(jnp.float32)) / GLA_GATE_TEMP
    q = q.astype(jnp.float32).reshape(B, L, GLA_HEADS, GLA_DK) * (GLA_DK ** -0.5)
    k = k.astype(jnp.float32).reshape(B, L, GLA_HEADS, GLA_DK)
    v = v.astype(jnp.float32).reshape(B, L, GLA_HEADS, GLA_DV)
    log_a = log_a.reshape(B, L, GLA_HEADS, GLA_DK)
    C = min(GLA_CHUNK, L)
    n_chunks = -(-L // C)
    pad = n_chunks * C - L

    def to_chunks(t):
        t = jnp.pad(t, ((0, 0), (0, pad), (0, 0), (0, 0)))
        t = t.reshape(B, n_chunks, C, GLA_HEADS, t.shape[-1])
        return jnp.transpose(t, (1, 0, 3, 2, 4))

    mask = jnp.tril(jnp.ones((C, C), dtype=bool))[:, :, None]

    def step(S, inp):
        qc, kc, vc, lac = inp
        bcum = jnp.cumsum(lac, axis=2)
        diff = bcum[:, :, :, None, :] - bcum[:, :, None, :, :]
        decay = jnp.exp(jnp.where(mask, diff, -jnp.inf))
        attn = jnp.einsum('bhik,bhjk,bhijk->bhij', qc, kc, decay)
        o = jnp.einsum('bhij,bhjv->bhiv', attn, vc) + \
            jnp.einsum('bhik,bhkv->bhiv', qc * jnp.exp(bcum), S)
        b_last = bcum[:, :, -1:, :]
        S_new = S * jnp.exp(b_last[:, :, 0, :, None]) + \
            jnp.einsum('bhjk,bhjv->bhkv', kc * jnp.exp(b_last - bcum), vc)
        return S_new, o

    S_final, o = lax.scan(step, s0.astype(jnp.float32),
                          (to_chunks(q), to_chunks(k), to_chunks(v), to_chunks(log_a)))
    o = jnp.transpose(o, (1, 0, 3, 2, 4)).reshape(B, n_chunks * C, GLA_HEADS, GLA_DV)[:, :L]
    o = o * lax.rsqrt(jnp.mean(jnp.square(o), axis=-1, keepdims=True) + RMS_EPS) * norm_w.astype(jnp.float32)
    o = o.reshape(B, L, V) * jax.nn.silu(og.astype(jnp.float32))
    y = jnp.einsum('blv,vd->bld', o.astype(x.dtype), w_out)
    return y, S_final.astype(x.dtype)


def sq_relu_mlp(x, w1, b1, w2, b2):
    h = jnp.square(jax.nn.relu(jnp.einsum('bld,df->blf', x, w1) + b1))
    return jnp.einsum('blf,fd->bld', h, w2) + b2


def trunk(x, pool_ctx, gla_init, pos0, pool_w, pool_scale, gla_w_in, gla_w_gate_up, gla_gate_bias,
          gla_norm_w, gla_w_out, ln_mix_g, ln_mix_b, mlp_w1, mlp_b1, mlp_w2, mlp_b2, ln_ffn_g, ln_ffn_b):
    pool_states, gla_states = [], []
    for i in range(DEPTH):
        j = i // N_MIXERS
        if i % N_MIXERS == 0:
            ctx = x[:, :0] if pool_ctx is None else pool_ctx[j]
            h, st = pool_mixer(ctx, x, pos0, pool_w[j], pool_scale[j])
            pool_states.append(st)
        else:
            s0 = (jnp.zeros((x.shape[0], GLA_HEADS, GLA_DK, GLA_DV), jnp.float32)
                  if gla_init is None else gla_init[j])
            h, st = gla_mixer(x, s0, gla_w_in[j], gla_w_gate_up[j], gla_gate_bias[j],
                              gla_norm_w[j], gla_w_out[j])
            gla_states.append(st)
        x = layer_norm(DN_ALPHA * x + h, ln_mix_g[i], ln_mix_b[i])
        x = layer_norm(DN_ALPHA * x + sq_relu_mlp(x, mlp_w1[i], mlp_b1[i], mlp_w2[i], mlp_b2[i]),
                       ln_ffn_g[i], ln_ffn_b[i])
    return x, jnp.stack(pool_states), jnp.stack(gla_states)


def setup_inputs(seed: int = 0) -> dict:
    key = jax.random.key(seed)
    ks = jax.random.split(key, 24)
    f32 = jnp.float32
    nrm = lambda k, shape, s: jax.random.normal(k, shape, f32) * s
    return {
        "x_prompt": nrm(ks[0], (BATCH, SEQ, D_MODEL), 1.0),
        "x_sample": nrm(ks[1], (DEC_BATCH, DEC_SEQ, D_MODEL), 1.0),
        "state_pool": nrm(ks[2], (N_POOL_LAYERS, DEC_BATCH, POOL_CTX, D_MODEL), 1.0),
        "state_gla": nrm(ks[3], (N_GLA_LAYERS, DEC_BATCH, GLA_HEADS, GLA_DK, GLA_DV), 0.5),
        "pool_w": nrm(ks[4], (N_POOL_LAYERS, N_POOL_GROUPS, POOL_GROUP, POOL_GROUP), POOL_GROUP ** -0.5 * DN_BETA),
        "pool_scale": 1.0 + nrm(ks[5], (N_POOL_LAYERS, D_MODEL), 0.1),
        "gla_w_in": nrm(ks[6], (N_GLA_LAYERS, D_MODEL, GLA_IN), D_MODEL ** -0.5),
        "gla_w_gate_up": nrm(ks[7], (N_GLA_LAYERS, GLA_GATE_RANK, GLA_KEY_DIM), GLA_GATE_RANK ** -0.5),
        "gla_gate_bias": nrm(ks[8], (N_GLA_LAYERS, GLA_KEY_DIM), 0.1),
        "gla_norm_w": 1.0 + nrm(ks[9], (N_GLA_LAYERS, GLA_DV), 0.1),
        "gla_w_out": nrm(ks[10], (N_GLA_LAYERS, GLA_VAL_DIM, D_MODEL), GLA_VAL_DIM ** -0.5 * DN_BETA),
        "ln_mix_g": 1.0 + nrm(ks[11], (DEPTH, D_MODEL), 0.1),
        "ln_mix_b": nrm(ks[12], (DEPTH, D_MODEL), 0.02),
        "mlp_w1": nrm(ks[13], (DEPTH, D_MODEL, D_FF), D_MODEL ** -0.5),
        "mlp_b1": nrm(ks[14], (DEPTH, D_FF), 0.02),
        "mlp_w2": nrm(ks[15], (DEPTH, D_FF, D_MODEL), D_FF ** -0.5 * DN_BETA),
        "mlp_b2": nrm(ks[16], (DEPTH, D_MODEL), 0.02),
        "ln_ffn_g": 1.0 + nrm(ks[17], (DEPTH, D_MODEL), 0.1),
        "ln_ffn_b": nrm(ks[18], (DEPTH, D_MODEL), 0.02),
    }


def reference(x_prompt, x_sample, state_pool, state_gla, pool_w, pool_scale, gla_w_in, gla_w_gate_up,
              gla_gate_bias, gla_norm_w, gla_w_out, ln_mix_g, ln_mix_b, mlp_w1, mlp_b1, mlp_w2, mlp_b2,
              ln_ffn_g, ln_ffn_b):
    y_prompt, new_pool_prompt, new_gla_prompt = trunk(
        x_prompt, None, None, 0, pool_w, pool_scale, gla_w_in, gla_w_gate_up, gla_gate_bias,
        gla_norm_w, gla_w_out, ln_mix_g, ln_mix_b, mlp_w1, mlp_b1, mlp_w2, mlp_b2, ln_ffn_g, ln_ffn_b)
    y_sample, new_pool_sample, new_gla_sample = trunk(
        x_sample, state_pool, state_gla, PAST_LEN - POOL_CTX, pool_w, pool_scale, gla_w_in,
        gla_w_gate_up, gla_gate_bias, gla_norm_w, gla_w_out, ln_mix_g, ln_mix_b, mlp_w1, mlp_b1,
        mlp_w2, mlp_b2, ln_ffn_g, ln_ffn_b)
    return (y_prompt, y_sample, new_pool_prompt, new_gla_prompt, new_pool_sample, new_gla_sample)
```

```cpp
#include <hip/hip_runtime.h>
#include <cstdio>
#include <cstdint>

#ifndef MK_N_LAUNCHES
#define MK_N_LAUNCHES 1
#endif

#define GAS __attribute__((address_space(1)))
#define LAS __attribute__((address_space(3)))
typedef unsigned short bf16;
typedef unsigned v4u __attribute__((ext_vector_type(4)));
typedef unsigned v2u __attribute__((ext_vector_type(2)));
typedef float f32x4 __attribute__((ext_vector_type(4)));
typedef float f32x16 __attribute__((ext_vector_type(16)));
typedef short bf16x8 __attribute__((ext_vector_type(8)));

constexpr int D = 2048, MP = 8192, MS = 128, MT = 8320, DFF = 8192, SEQ = 2048, NBAT = 4, NH = 4, DK = 256, DV = 512, KD = 1024;
constexpr int GIN = 6160, NRANK = 16, CH = 64, NCH = 32, PCTX = 15;
constexpr float ALPHA = 1.6817928305074290f;
constexpr float LN_EPS = 1e-5f, RMS_EPS = 1e-5f;
constexpr int NPHASE = 31;
constexpr int NWAVES = 8;

constexpr size_t O_YP = 0, O_YS = 16777216, O_PP = 17039360, O_GP = 17285120, O_PS = 21479424, O_GS = 29343744, O_END = 163561472;

constexpr size_t MiB = 1u << 20;
constexpr size_t WS_CTL = 0, CTL_ZERO_BYTES = 1 * MiB;
constexpr size_t WS_WP = 1 * MiB, WS_WIN = 5 * MiB, WS_WOUT = 54 * MiB, WS_W1 = 70 * MiB, WS_W2 = 198 * MiB;
constexpr size_t WS_X32 = 326 * MiB, WS_XB = 391 * MiB, WS_Y32 = 424 * MiB, WS_PB = 488 * MiB, WS_OB = 521 * MiB, WS_HB = 554 * MiB;
constexpr size_t WS_QK = 684 * MiB, WS_OG = 716 * MiB, WS_VT = 748 * MiB, WS_QT = 780 * MiB, WS_KT = 812 * MiB, WS_ST = 828 * MiB;
constexpr size_t WS_DEC = 956 * MiB, WS_GKL = 957 * MiB, WS_SQKV = 958 * MiB, WS_SLAB = 961 * MiB, WS_PAR = 965 * MiB, WS_WSUM = 966 * MiB, WS_END = 968 * MiB;
constexpr int PAR_PSCALE = 0, PAR_WGU = 4096, PAR_GBIAS = 36864, PAR_NORMW = 38912, PAR_LNMG = 39936, PAR_LNMB = 48128, PAR_B1 = 56320, PAR_B2 = 89088, PAR_LNFG = 97280, PAR_LNFB = 105472, PAR_END = 113664;
constexpr size_t WIN_LAYER = (size_t)GIN * D;
constexpr int CW_BAR = 4096;

constexpr int LDS_BYTES = 147456;
constexpr int MISC_OFF = 147200;

__device__ __forceinline__ unsigned cvt_pk_bf16(float lo, float hi) { unsigned r; asm volatile("v_cvt_pk_bf16_f32 %0, %1, %2" : "=v"(r) : "v"(lo), "v"(hi)); return r; }
__device__ __forceinline__ float bf2f(unsigned short b) { return __uint_as_float(((unsigned)b) << 16); }
__device__ __forceinline__ float wave_sum(float v) {
#pragma unroll
    for (int o = 1; o < 64; o <<= 1) v += __shfl_xor(v, o);
    return v;
}
__device__ __forceinline__ float logsigmoidf(float x) { return fminf(x, 0.f) - log1pf(expf(-fabsf(x))); }
__device__ __forceinline__ int fresh_tid() { int t = threadIdx.x; asm volatile("" : "+v"(t)); return t; }
#define LDS_WAIT() asm volatile("s_waitcnt lgkmcnt(0)" ::: "memory")
#define VM_WAIT() asm volatile("s_waitcnt vmcnt(0)" ::: "memory")

namespace pg8 {
#define PG8_LAS __attribute__((address_space(3)))
typedef unsigned short bf16_t;
typedef unsigned u32x4 __attribute__((ext_vector_type(4)));
constexpr int BM = 256, BK = 64, HALF = 128, HTB = HALF * BK * 2, STAGE_BYTES = 8 * HTB, NXCD = 8, WGM = 8;

__host__ __device__ __forceinline__ int lds_byte(int r, int c) { const int st = (r >> 4) * 2 + (c >> 5), rr = r & 15, cc = c & 31, ob = rr * 64 + cc * 2; return st * 1024 + (ob ^ (((ob >> 9) & 1) << 5)); }
__host__ __device__ __forceinline__ void stage_rc(int b, int& R, int& C) { const int st = b / 1024, sb = b % 1024, swz = sb ^ (((sb >> 9) & 1) << 5); R = (st >> 1) * 16 + swz / 64; C = (st & 1) * 32 + (swz % 64) / 2; }
__host__ __device__ __forceinline__ int perm32(int rho) { const int n = rho >> 4, i = rho & 15; return 8 * (i >> 2) + 4 * n + (i & 3); }

struct Unit { int pm, pn; };
struct Gemm { const bf16_t* A; const bf16_t* Bt; int lda, ldb, K, a_shift, a_step; };

struct StaticOrder {
    int nM, nN, nwg, G, c;
    __host__ __device__ void init(int M, int N, int G_, int c_) { nM = M / BM; nN = N / BM; nwg = nM * nN; G = G_; c = c_; }
    __host__ __device__ bool next(int i, Unit& u) const {
        const long L = (long)i * G + c; if (L >= nwg) return false;
        int wgid = (int)L; { const int q = nwg / NXCD, r = nwg % NXCD, xcd = wgid % NXCD, off = wgid / NXCD; wgid = (xcd < r ? xcd * (q + 1) : r * (q + 1) + (xcd - r) * q) + off; }
        const int nig = WGM * nN, gid = wgid / nig, fm = gid * WGM, gsz = (nM - fm) < WGM ? (nM - fm) : WGM;
        u.pm = fm + ((wgid % nig) % gsz); u.pn = (wgid % nig) / gsz; return true;
    }
    __device__ __forceinline__ void a_ready(const Unit&) const {}
    __device__ __forceinline__ void done(const Unit&) const {}
};

struct EpiF32 {
    static constexpr bool PERM = false, AFTER_DRAIN = false;
    float* C; int ldc;
    __device__ __forceinline__ void operator()(const f32x4 (&acc)[2][2][4][2], const Unit& u, int wr, int wc, int fr, int fq) const {
        const int row0 = u.pm * BM + wr * 64 + fr, col0 = u.pn * BM + wc * 32 + 4 * fq;
#pragma unroll
        for (int ai = 0; ai < 2; ++ai)
#pragma unroll
            for (int m = 0; m < 4; ++m) { float* rowp = C + (size_t)(row0 + ai * HALF + m * 16) * ldc + col0;
#pragma unroll
                for (int bj = 0; bj < 2; ++bj)
#pragma unroll
                    for (int n = 0; n < 2; ++n) *(f32x4*)(rowp + bj * HALF + n * 16) = acc[ai][bj][m][n]; }
    }
};
template <int ACT  > struct EpiBf16 {
    static constexpr bool PERM = true, AFTER_DRAIN = false;
    bf16_t* O; int ldc; const float* bias; int split_cols; size_t split_stride;
    __device__ __forceinline__ void operator()(const f32x4 (&acc)[2][2][4][2], const Unit& u, int wr, int wc, int fr, int fq) const {
        const int row0 = u.pm * BM + wr * 64 + fr; int colt = u.pn * BM; bf16_t* base = O;
        if (split_cols) { const int t = colt / split_cols; base += (size_t)t * split_stride; colt -= t * split_cols; }
        const int col0 = colt + wc * 32 + 8 * fq, bcol0 = u.pn * BM + wc * 32 + 8 * fq;
        f32x4 bv[2][2];
#pragma unroll
        for (int bj = 0; bj < 2; ++bj)
#pragma unroll
            for (int n = 0; n < 2; ++n) bv[bj][n] = bias ? *(const f32x4*)(bias + bcol0 + bj * HALF + 4 * n) : (f32x4){0.f, 0.f, 0.f, 0.f};
#pragma unroll
        for (int ai = 0; ai < 2; ++ai)
#pragma unroll
            for (int m = 0; m < 4; ++m) { bf16_t* rowp = base + (size_t)(row0 + ai * HALF + m * 16) * ldc + col0;
#pragma unroll
                for (int bj = 0; bj < 2; ++bj) { f32x4 v0 = acc[ai][bj][m][0] + bv[bj][0], v1 = acc[ai][bj][m][1] + bv[bj][1];
                    if (ACT == 1) {
#pragma unroll
                        for (int j = 0; j < 4; ++j) { const float a = fmaxf(v0[j], 0.f), b = fmaxf(v1[j], 0.f); v0[j] = a * a; v1[j] = b * b; } }
                    u32x4 w; w.x = cvt_pk_bf16(v0[0], v0[1]); w.y = cvt_pk_bf16(v0[2], v0[3]); w.z = cvt_pk_bf16(v1[0], v1[1]); w.w = cvt_pk_bf16(v1[2], v1[3]);
                    *(u32x4*)(rowp + bj * HALF) = w; } }
    }
};

template <class Epi, class Sched, bool ALIGN_EPI = false>
__device__ __forceinline__ void gemm_phase(PG8_LAS unsigned char* lds, const Gemm g, const Sched& S, const Epi& E) {
    const int tid = fresh_tid(), wid = __builtin_amdgcn_readfirstlane(tid >> 6), lane = tid & 63, wr = wid >> 2, wc = wid & 3, fr = lane & 15, fq = lane >> 4;
    const int K = g.K, nt = K / BK;
    unsigned voffA[2], voffB[2];
#pragma unroll
    for (int i = 0; i < 2; ++i) { int R, C; stage_rc(tid * 16 + i * 8192, R, C); const int Rb = Epi::PERM ? ((R & ~31) + perm32(R & 31)) : R;
        voffA[i] = (unsigned)(R * g.lda + C) * 2u; voffB[i] = (unsigned)(Rb * g.ldb + C) * 2u; }
    const size_t kstep = (size_t)(BK * 2);
    const size_t hstepA = (size_t)HALF * g.lda * 2, hstepB = (size_t)HALF * g.ldb * 2;
    const size_t tstepA = 2 * hstepA, tstepB = 2 * hstepB;
    const unsigned ldsw = (unsigned)wid * 1024u;
    const int aoff = lds_byte(wr * 64 + fr, fq * 8), boff = lds_byte(wc * 32 + fr, fq * 8);
#define PG8_SA(b, h) (((b) * 2 + (h)) * HTB)
#define PG8_SB(b, h) ((4 + (b) * 2 + (h)) * HTB)
#define PG8_STAGE(bufoff, gbase, voff) do { _Pragma("unroll") for (int _i = 0; _i < 2; ++_i) \
        __builtin_amdgcn_global_load_lds((const unsigned*)((const char*)(gbase) + (voff)[_i]), (PG8_LAS unsigned*)(lds + (bufoff) + ldsw + _i * 8192), 16, 0, 0); } while (0)
#define PG8_LDA(dst, b, h) do { _Pragma("unroll") for (int m = 0; m < 4; ++m) _Pragma("unroll") for (int k = 0; k < 2; ++k) dst[m][k] = *(const PG8_LAS bf16x8*)(lds + PG8_SA(b, h) + aoff + m * 2048 + k * 1024); } while (0)
#define PG8_LDB(dst, b, h) do { _Pragma("unroll") for (int n = 0; n < 2; ++n) _Pragma("unroll") for (int k = 0; k < 2; ++k) dst[n][k] = *(const PG8_LAS bf16x8*)(lds + PG8_SB(b, h) + boff + n * 2048 + k * 1024); } while (0)
#define PG8_MMA(ai, bj, At, Bt) do { __builtin_amdgcn_s_setprio(1); _Pragma("unroll") for (int m = 0; m < 4; ++m) _Pragma("unroll") for (int n = 0; n < 2; ++n) _Pragma("unroll") for (int k = 0; k < 2; ++k) \
        acc[ai][bj][m][n] = __builtin_amdgcn_mfma_f32_16x16x32_bf16(Bt[n][k], At[m][k], acc[ai][bj][m][n], 0, 0, 0); __builtin_amdgcn_s_setprio(0); } while (0)
#define PG8_WAIT_V(n) asm volatile("s_waitcnt vmcnt(" #n ")" ::: "memory")
#define PG8_WAIT_L(n) asm volatile("s_waitcnt lgkmcnt(" #n ")" ::: "memory")
#define PG8_BAR __builtin_amdgcn_s_barrier()
#define PG8_SCHED __builtin_amdgcn_sched_barrier(0)
#define PG8_APTR(u) ((const char*)g.A + (size_t)(u).pm * tstepA + (size_t)((u).pn >> g.a_shift) * (size_t)g.a_step)
#define PG8_BPTR(u) ((const char*)g.Bt + (size_t)(u).pn * tstepB)
    Unit cur, nxt; int ui = 0;
    if (!S.next(0, cur)) return;
    f32x4 acc[2][2][4][2];
#pragma unroll
    for (int a = 0; a < 2; ++a)
#pragma unroll
        for (int b = 0; b < 2; ++b)
#pragma unroll
            for (int m = 0; m < 4; ++m)
#pragma unroll
                for (int n = 0; n < 2; ++n) acc[a][b][m][n] = (f32x4){0.f, 0.f, 0.f, 0.f};
    bf16x8 At[4][2], B0[2][2], B1[2][2];
    const char* cA = PG8_APTR(cur); const char* cB = PG8_BPTR(cur);
    S.a_ready(cur);
    PG8_STAGE(PG8_SB(0, 0), cB, voffB); PG8_STAGE(PG8_SB(0, 1), cB + hstepB, voffB); PG8_STAGE(PG8_SA(0, 0), cA, voffA); PG8_STAGE(PG8_SA(0, 1), cA + hstepA, voffA);
    if (wr == 1) PG8_BAR;
    PG8_WAIT_V(2); PG8_BAR;
    PG8_STAGE(PG8_SB(1, 0), cB + kstep, voffB); PG8_STAGE(PG8_SA(1, 0), cA + kstep, voffA); PG8_STAGE(PG8_SB(1, 1), cB + hstepB + kstep, voffB);
    PG8_WAIT_V(6); PG8_BAR;
    for (;;) {
        const bool has_next = S.next(ui + 1, nxt);
        const char* nA = has_next ? PG8_APTR(nxt) : cA; const char* nB = has_next ? PG8_BPTR(nxt) : cB;
        for (int t = 0; t < nt; t += 2) {
            const bool last = (t == nt - 2);
            const char* a1 = cA + (size_t)(t + 1) * kstep;
            const char* a2 = last ? nA : cA + (size_t)(t + 2) * kstep; const char* b2 = last ? nB : cB + (size_t)(t + 2) * kstep;
            const char* a3 = a2 + kstep; const char* b3 = b2 + kstep;
            if (last && has_next) S.a_ready(nxt);
            PG8_LDB(B0, 0, 0); PG8_LDB(B1, 0, 1); PG8_SCHED; PG8_LDA(At, 0, 0); PG8_STAGE(PG8_SA(1, 1), a1 + hstepA, voffA);
            PG8_WAIT_V(8); PG8_WAIT_L(0); PG8_BAR; PG8_MMA(0, 0, At, B0); PG8_MMA(0, 1, At, B1); PG8_BAR; PG8_SCHED;
            PG8_LDA(At, 0, 1); PG8_STAGE(PG8_SB(0, 0), b2, voffB); PG8_STAGE(PG8_SB(0, 1), b2 + hstepB, voffB); PG8_STAGE(PG8_SA(0, 0), a2, voffA);
            PG8_WAIT_V(8); PG8_WAIT_L(0); PG8_BAR; PG8_MMA(1, 0, At, B0); PG8_MMA(1, 1, At, B1); PG8_BAR; PG8_SCHED;
            PG8_LDB(B0, 1, 0); PG8_LDB(B1, 1, 1); PG8_SCHED; PG8_LDA(At, 1, 0); PG8_STAGE(PG8_SA(0, 1), a2 + hstepA, voffA);
            PG8_WAIT_V(8); PG8_WAIT_L(0); PG8_BAR; PG8_MMA(0, 0, At, B0); PG8_MMA(0, 1, At, B1); PG8_BAR; PG8_SCHED;
            PG8_LDA(At, 1, 1); PG8_STAGE(PG8_SB(1, 0), b3, voffB); PG8_STAGE(PG8_SB(1, 1), b3 + hstepB, voffB); PG8_STAGE(PG8_SA(1, 0), a3, voffA);
            PG8_WAIT_V(8); PG8_WAIT_L(0); PG8_BAR; PG8_MMA(1, 0, At, B0); PG8_MMA(1, 1, At, B1); PG8_BAR; PG8_SCHED;
        }
        if constexpr (ALIGN_EPI) { if (wr == 0) PG8_BAR; }
        E(acc, cur, wr, wc, fr, fq); S.done(cur);
        if (!has_next) break;
#pragma unroll
        for (int a = 0; a < 2; ++a)
#pragma unroll
            for (int b = 0; b < 2; ++b)
#pragma unroll
                for (int m = 0; m < 4; ++m)
#pragma unroll
                    for (int n = 0; n < 2; ++n) acc[a][b][m][n] = (f32x4){0.f, 0.f, 0.f, 0.f};
        cur = nxt; cA = nA; cB = nB; ++ui;
        if constexpr (ALIGN_EPI) { if (wr == 1) PG8_BAR; }
    }
    PG8_WAIT_V(0);
    if constexpr (!ALIGN_EPI) { if (wr == 0) PG8_BAR; }
    PG8_BAR;
#undef PG8_SA
#undef PG8_SB
#undef PG8_STAGE
#undef PG8_LDA
#undef PG8_LDB
#undef PG8_MMA
#undef PG8_WAIT_V
#undef PG8_WAIT_L
#undef PG8_BAR
#undef PG8_SCHED
#undef PG8_APTR
#undef PG8_BPTR
}
}

#define XB_TMO      128
#define XB_XCNT(j)  (256  + 64 * (j))
#define XB_XSUB(j)  (1280 + 64 * (j))
#define XB_XGEN(j)  (2304 + 64 * (j))
#define XB_TOP      3328
#define XB_TOPGEN   3392
#define XCD_BAR_WORDS 3456
#define XB_SPIN_CAP (1u << 18)

__device__ __forceinline__ unsigned xb_ld(unsigned* p)              { return __hip_atomic_load(p, __ATOMIC_RELAXED, __HIP_MEMORY_SCOPE_AGENT); }
__device__ __forceinline__ unsigned xb_add(unsigned* p, unsigned v) { return __hip_atomic_fetch_add(p, v, __ATOMIC_RELAXED, __HIP_MEMORY_SCOPE_AGENT); }
__device__ __forceinline__ unsigned xb_xcc_id() { return (unsigned)__builtin_amdgcn_s_getreg((3 << 11) | 20) & 0xFu; }
#define XB_SPIN(cond, bar) do { unsigned _sp = 0; while (cond) { __builtin_amdgcn_s_sleep(1); \
    if ((++_sp & 255u) == 0u) { if (xb_ld(&(bar)[XB_TMO])) break; if (_sp > XB_SPIN_CAP) { atomicAdd(&(bar)[XB_TMO], 1u); break; } } } } while (0)

struct XcdBarrier { unsigned* bar; unsigned x; volatile LAS unsigned* st; };

__device__ __forceinline__ XcdBarrier xcd_barrier_post(unsigned* bar, volatile LAS unsigned* st) {
    XcdBarrier b; b.bar = bar; b.x = xb_xcc_id(); b.st = st;
    if (threadIdx.x == 0) (void)xb_add(&bar[XB_XCNT(b.x)], 1u);
    return b;
}
__device__ __forceinline__ void xcd_barrier_complete(unsigned* bar, unsigned x, unsigned& nloc, unsigned& nx) {
    const unsigned G = gridDim.x * gridDim.y * gridDim.z;
    unsigned sum, cnt, mine, sp = 0u;
    for (;;) {
        sum = 0u; cnt = 0u; mine = 0u;
#pragma unroll
        for (unsigned j = 0; j < 16; ++j) { const unsigned c = xb_ld(&bar[XB_XCNT(j)]); sum += c; cnt += (c > 0u) ? 1u : 0u; mine = (j == x) ? c : mine; }
        if (sum == G) break;
        __builtin_amdgcn_s_sleep(1);
        if ((++sp & 255u) == 0u) { if (xb_ld(&bar[XB_TMO])) break; if (sp > XB_SPIN_CAP) { atomicAdd(&bar[XB_TMO], 1u); break; } }
    }
    nloc = mine > 0u ? mine : 1u; nx = cnt > 0u ? cnt : 1u;
}
__device__ __forceinline__ void xcd_barrier(const XcdBarrier& b) {
    asm volatile("s_waitcnt vmcnt(0)" ::: "memory");
    __syncthreads();
    if (threadIdx.x == 0) {
        unsigned* bar = b.bar;
        __builtin_amdgcn_s_waitcnt(0);
        unsigned nloc = b.st[0], nx = b.st[1];
        if (nloc == 0u) { xcd_barrier_complete(bar, b.x, nloc, nx); b.st[0] = nloc; b.st[1] = nx; }
        const unsigned old = xb_add(&bar[XB_XSUB(b.x)], 1u);
        const unsigned gen = old / nloc;
        if (old + 1u == (gen + 1u) * nloc) {
            __builtin_amdgcn_fence(__ATOMIC_RELEASE, "agent");
            asm volatile("s_waitcnt vmcnt(0)" ::: "memory");
            const unsigned og = xb_add(&bar[XB_TOP], 1u);
            const unsigned tg = og / nx;
            if (og + 1u == (tg + 1u) * nx) xb_add(&bar[XB_TOPGEN], 1u);
            else XB_SPIN(xb_ld(&bar[XB_TOPGEN]) == tg, bar);
            __builtin_amdgcn_fence(__ATOMIC_ACQUIRE, "agent");
            xb_add(&bar[XB_XGEN(b.x)], 1u);
            asm volatile("s_waitcnt vmcnt(0)" ::: "memory");
        } else {
            XB_SPIN(xb_ld(&bar[XB_XGEN(b.x)]) == gen, bar);
            __builtin_amdgcn_fence(__ATOMIC_ACQUIRE, "agent");
            asm volatile("s_waitcnt vmcnt(0)" ::: "memory");
        }
    }
    __syncthreads();
}

__device__ __forceinline__ void tr_item(const float* W, int ldw, int k0, int n0, bf16* WT, int ldk, int drow0, LAS float* scr, int lane) {
    const int lc = lane & 15, lr = lane >> 4;
#pragma unroll 4
    for (int i = 0; i < 16; ++i) {
        const int kk = 4 * i + lr;
        const f32x4 v = *(const f32x4*)(W + (size_t)(k0 + kk) * ldw + n0 + 4 * lc);
        LAS float* s = scr + kk * 65 + 4 * lc;
        s[0] = v[0]; s[1] = v[1]; s[2] = v[2]; s[3] = v[3];
    }
    LDS_WAIT(); asm volatile("" ::: "memory");
    const int c = lane & 7;
#pragma unroll
    for (int j = 0; j < 8; ++j) { const int n = (lane >> 3) + 8 * j; const LAS float* s = scr + (8 * c) * 65 + n;
        v4u o; o.x = cvt_pk_bf16(s[0 * 65], s[1 * 65]); o.y = cvt_pk_bf16(s[2 * 65], s[3 * 65]); o.z = cvt_pk_bf16(s[4 * 65], s[5 * 65]); o.w = cvt_pk_bf16(s[6 * 65], s[7 * 65]);
        *(v4u*)(WT + (size_t)(drow0 + n) * ldk + k0 + 8 * c) = o; }
    LDS_WAIT(); asm volatile("" ::: "memory");
}

struct Ctx { unsigned char* ws; float* out; const float* sgla; };
struct Ptrs {
    const float *state_gla, *pool_scale, *w_gu, *gate_bias, *norm_w, *ln_mix_g, *ln_mix_b, *b1, *b2, *ln_ffn_g, *ln_ffn_b, *WSUM;
    float* out;
    bf16 *WP, *WIN, *WOUT, *W1, *W2, *XB, *PB, *OB, *HB, *QK, *OG, *VT, *QT, *KT, *ST;
    float *X32, *Y32, *DEC, *GKL, *SQKV, *SLAB;
};
__device__ __forceinline__ Ptrs make_ptrs(const Ctx& C) {
    Ptrs P; unsigned char* ws = C.ws; float* par = (float*)(ws + WS_PAR);
    P.state_gla = C.sgla; P.out = C.out;
    P.pool_scale = par + PAR_PSCALE; P.w_gu = par + PAR_WGU; P.gate_bias = par + PAR_GBIAS; P.norm_w = par + PAR_NORMW; P.ln_mix_g = par + PAR_LNMG; P.ln_mix_b = par + PAR_LNMB;
    P.b1 = par + PAR_B1; P.b2 = par + PAR_B2; P.ln_ffn_g = par + PAR_LNFG; P.ln_ffn_b = par + PAR_LNFB; P.WSUM = (const float*)(ws + WS_WSUM);
    P.WP = (bf16*)(ws + WS_WP); P.WIN = (bf16*)(ws + WS_WIN); P.WOUT = (bf16*)(ws + WS_WOUT); P.W1 = (bf16*)(ws + WS_W1); P.W2 = (bf16*)(ws + WS_W2);
    P.XB = (bf16*)(ws + WS_XB); P.PB = (bf16*)(ws + WS_PB); P.OB = (bf16*)(ws + WS_OB); P.HB = (bf16*)(ws + WS_HB);
    P.QK = (bf16*)(ws + WS_QK); P.OG = (bf16*)(ws + WS_OG); P.VT = (bf16*)(ws + WS_VT); P.QT = (bf16*)(ws + WS_QT); P.KT = (bf16*)(ws + WS_KT); P.ST = (bf16*)(ws + WS_ST);
    P.X32 = (float*)(ws + WS_X32); P.Y32 = (float*)(ws + WS_Y32); P.DEC = (float*)(ws + WS_DEC); P.GKL = (float*)(ws + WS_GKL); P.SQKV = (float*)(ws + WS_SQKV); P.SLAB = (float*)(ws + WS_SLAB);
    return P;
}

struct Args { const float* in[19]; float* out; unsigned char* ws; int ph_lo, ph_hi; };
__device__ __forceinline__ void copy_par(const float* src, float* dst, int n, int gtid, int NGT) { for (int e = gtid; e < n; e += NGT) dst[e] = src[e]; }
__device__ __forceinline__ void prologue_phase(const Args& A, LAS unsigned char* lds, int bid, int G) {
    const int tid = fresh_tid(), lane = tid & 63, wave = __builtin_amdgcn_readfirstlane(tid >> 6);
    const int gw = bid * NWAVES + wave, NGW = G * NWAVES, gtid = bid * (NWAVES * 64) + tid, NGT = G * NWAVES * 64;
    unsigned char* ws = A.ws;
    const float *xp = A.in[0], *xs = A.in[1], *state_pool = A.in[2], *pool_w = A.in[4], *w_in = A.in[6], *w_out = A.in[10], *w1 = A.in[13], *w2 = A.in[15];
    bf16 *WP = (bf16*)(ws + WS_WP), *WIN = (bf16*)(ws + WS_WIN), *WOUT = (bf16*)(ws + WS_WOUT), *W1 = (bf16*)(ws + WS_W1), *W2 = (bf16*)(ws + WS_W2);
    LAS float* scr = (LAS float*)(lds + wave * 16640);
    constexpr int T_POOL = 8 * 64, T_IN = 2 * 32 * 96, T_OUT = 2 * 32 * 32, T_1 = 4 * 32 * 128, T_2 = 4 * 128 * 32;
    constexpr int NT = T_POOL + T_IN + T_OUT + T_1 + T_2;
    for (int it = gw; it < NT; it += NGW) {
        int r = it;
        if (r < T_POOL) { const int mtx = r >> 6, t = r & 63, kb = t >> 3, nb = t & 7;
            tr_item(pool_w + (size_t)mtx * 512 * 512, 512, kb * 64, nb * 64, WP + (size_t)mtx * 512 * 512, 512, nb * 64, scr, lane); continue; }
        r -= T_POOL;
        if (r < T_IN) { const int l = r / (32 * 96), t = r % (32 * 96), kb = t / 96, nb = t % 96; const int n0 = nb * 64;
            const int drow = n0 < 2048 ? n0 : (n0 < 4096 ? n0 + 2048 : n0 - 2048);
            tr_item(w_in + (size_t)l * D * GIN, GIN, kb * 64, n0, WIN + (size_t)l * WIN_LAYER, D, drow, scr, lane); continue; }
        r -= T_IN;
        if (r < T_OUT) { const int l = r >> 10, t = r & 1023, kb = t >> 5, nb = t & 31;
            tr_item(w_out + (size_t)l * D * D, D, kb * 64, nb * 64, WOUT + (size_t)l * D * D, D, nb * 64, scr, lane); continue; }
        r -= T_OUT;
        if (r < T_1) { const int l = r >> 12, t = r & 4095, kb = t >> 7, nb = t & 127;
            tr_item(w1 + (size_t)l * D * DFF, DFF, kb * 64, nb * 64, W1 + (size_t)l * D * DFF, D, nb * 64, scr, lane); continue; }
        r -= T_1;
        { const int l = r >> 12, t = r & 4095, kb = t >> 5, nb = t & 31;
            tr_item(w2 + (size_t)l * DFF * D, D, kb * 64, nb * 64, W2 + (size_t)l * DFF * D, DFF, nb * 64, scr, lane); }
    }
    for (int e = gtid; e < 2 * NRANK * D; e += NGT) { const int l = e / (NRANK * D), rem = e % (NRANK * D), n = rem / D, k = rem % D;
        const float v = w_in[(size_t)l * D * GIN + (size_t)k * GIN + 6144 + n];
        WIN[(size_t)l * WIN_LAYER + (size_t)(6144 + n) * D + k] = (bf16)(cvt_pk_bf16(v, 0.f) & 0xffffu); }
    float* X32 = (float*)(ws + WS_X32); bf16* XB = (bf16*)(ws + WS_XB);
    for (int e = gtid; e < MT * D / 4; e += NGT) {
        const size_t o = (size_t)e * 4; const int r = (int)(o / D);
        const f32x4 v = r < MP ? *(const f32x4*)(xp + o) : *(const f32x4*)(xs + (o - (size_t)MP * D));
        *(f32x4*)(X32 + o) = v;
        v2u w; w.x = cvt_pk_bf16(v[0], v[1]); w.y = cvt_pk_bf16(v[2], v[3]); *(v2u*)(XB + o) = w;
    }
    float* par = (float*)(ws + WS_PAR);
    copy_par(A.in[5], par + PAR_PSCALE, 2 * D, gtid, NGT);           copy_par(A.in[7], par + PAR_WGU, 2 * NRANK * KD, gtid, NGT);
    copy_par(A.in[8], par + PAR_GBIAS, 2 * KD, gtid, NGT);           copy_par(A.in[9], par + PAR_NORMW, 2 * DV, gtid, NGT);
    copy_par(A.in[11], par + PAR_LNMG, 4 * D, gtid, NGT);            copy_par(A.in[12], par + PAR_LNMB, 4 * D, gtid, NGT);
    copy_par(A.in[14], par + PAR_B1, 4 * DFF, gtid, NGT);            copy_par(A.in[16], par + PAR_B2, 4 * D, gtid, NGT);
    copy_par(A.in[17], par + PAR_LNFG, 4 * D, gtid, NGT);            copy_par(A.in[18], par + PAR_LNFB, 4 * D, gtid, NGT);
    float* WSUM = (float*)(ws + WS_WSUM);
    for (int e = gtid; e < 2 * MS * (D / 4); e += NGT) {
        const int c = (e % (D / 4)) * 4, js = e / (D / 4);
        const int w = 2 << (c >> 9);
        const float* ctx = state_pool + (size_t)js * PCTX * D + c;
        float* octx = A.out + O_PS + (size_t)js * PCTX * D + c;
        f32x4 s = (f32x4){0.f, 0.f, 0.f, 0.f};
        for (int i = 0; i < PCTX; ++i) { const f32x4 cv = *(const f32x4*)(ctx + (size_t)i * D);
            if (i >= PCTX - (w - 1)) s += cv;
            if (i >= 1) *(f32x4*)(octx + (size_t)(i - 1) * D) = cv; }
        *(f32x4*)(WSUM + (size_t)js * D + c) = s;
    }
}

__device__ __forceinline__ void ln_phase(const Ptrs& P, int nsplit, const float* bias, const float* scale, const float* gam, const float* bet, bool last, int gw, int NGW, int lane) {
    for (int r = gw; r < MT; r += NGW) {
        f32x4 v[8];
        const float* xr = P.X32 + (size_t)r * D;
        if (r < MP) { const float* yr = P.Y32 + (size_t)r * D;
#pragma unroll
            for (int j = 0; j < 8; ++j) v[j] = *(const f32x4*)(yr + 4 * lane + 256 * j);
        } else {
#pragma unroll
            for (int j = 0; j < 8; ++j) v[j] = (f32x4){0.f, 0.f, 0.f, 0.f};
            for (int s = 0; s < nsplit; ++s) { const float* yr = P.SLAB + ((size_t)s * MS + (r - MP)) * D;
#pragma unroll
                for (int j = 0; j < 8; ++j) v[j] += *(const f32x4*)(yr + 4 * lane + 256 * j); }
        }
        float sum = 0.f;
#pragma unroll
        for (int j = 0; j < 8; ++j) { const int c = 4 * lane + 256 * j;
            if (bias) v[j] += *(const f32x4*)(bias + c);
            if (scale) v[j] *= *(const f32x4*)(scale + c);
            v[j] += ALPHA * *(const f32x4*)(xr + c);
            sum += (v[j][0] + v[j][1]) + (v[j][2] + v[j][3]); }
        const float mean = wave_sum(sum) * (1.f / D); float s2 = 0.f;
#pragma unroll
        for (int j = 0; j < 8; ++j) { v[j] = v[j] - mean; s2 += (v[j][0] * v[j][0] + v[j][1] * v[j][1]) + (v[j][2] * v[j][2] + v[j][3] * v[j][3]); }
        const float rstd = 1.0f / sqrtf(wave_sum(s2) * (1.f / D) + LN_EPS);
        float* o32 = last ? (r < MP ? P.out + O_YP + (size_t)r * D : P.out + O_YS + (size_t)(r - MP) * D) : P.X32 + (size_t)r * D;
        bf16* ob = P.XB + (size_t)r * D;
#pragma unroll
        for (int j = 0; j < 8; ++j) { const int c = 4 * lane + 256 * j;
            const f32x4 y = v[j] * rstd * *(const f32x4*)(gam + c) + *(const f32x4*)(bet + c);
            *(f32x4*)(o32 + c) = y;
            if (!last) { v2u w; w.x = cvt_pk_bf16(y[0], y[1]); w.y = cvt_pk_bf16(y[2], y[3]); *(v2u*)(ob + c) = w; } }
    }
}

__device__ __forceinline__ void pool_prep_phase(const Ptrs& P, int j, int bid, int G, int tid) {
    const int c = tid * 4, g = tid >> 7, w = 2 << g;
    const float* X = P.X32;
    for (int blk = bid; blk < MP / 32; blk += G) {
        const int r0 = blk * 32, b = r0 / SEQ, l0 = r0 % SEQ;
        f32x4 s = (f32x4){0.f, 0.f, 0.f, 0.f};
        for (int i = 1; i < w; ++i) { const int l = l0 - i; if (l >= 0) s += *(const f32x4*)(X + (size_t)(b * SEQ + l) * D + c); }
        for (int t = 0; t < 32; ++t) {
            const int l = l0 + t; const size_t ro = (size_t)(r0 + t) * D + c;
            const f32x4 xv = *(const f32x4*)(X + ro);
            s += xv;
            const float inv = 1.0f / (float)(l + 1 < w ? l + 1 : w);
            const f32x4 p = s * inv - xv;
            v2u o; o.x = cvt_pk_bf16(p[0], p[1]); o.y = cvt_pk_bf16(p[2], p[3]); *(v2u*)(P.PB + ro) = o;
            const int lo = l - w + 1; if (lo >= 0) s -= *(const f32x4*)(X + (size_t)(b * SEQ + lo) * D + c);
            if (l >= SEQ - PCTX) *(f32x4*)(P.out + O_PP + ((size_t)(j * NBAT + b) * PCTX + (l - (SEQ - PCTX))) * D + c) = xv;
        }
    }
    for (int sidx = bid; sidx < MS; sidx += G) {
        const size_t ro = (size_t)(MP + sidx) * D + c;
        const f32x4 xv = *(const f32x4*)(X + ro);
        const f32x4 s = xv + *(const f32x4*)(P.WSUM + (size_t)(j * MS + sidx) * D + c);
        *(f32x4*)(P.out + O_PS + ((size_t)(j * MS + sidx) * PCTX + (PCTX - 1)) * D + c) = xv;
        const f32x4 p = s * (1.0f / (float)w) - xv;
        v2u o; o.x = cvt_pk_bf16(p[0], p[1]); o.y = cvt_pk_bf16(p[2], p[3]); *(v2u*)(P.PB + ro) = o;
    }
}

template <int NT, class F>
__device__ __forceinline__ void micro_unit(const bf16* A, int lda, const bf16* Bt, int ldb, int Kc, int wid, int lane, const F& store) {
    const int fr = lane & 15, fq = lane >> 4;
    const bf16* ap = A + (size_t)(wid * 16 + fr) * lda + fq * 8;
    const bf16* bp = Bt + (size_t)fr * ldb + fq * 8;
    f32x4 acc[NT];
#pragma unroll
    for (int n = 0; n < NT; ++n) acc[n] = (f32x4){0.f, 0.f, 0.f, 0.f};
    for (int k = 0; k < Kc; k += 128) {
        bf16x8 a[4], b[4][NT];
#pragma unroll
        for (int kk = 0; kk < 4; ++kk) { a[kk] = *(const bf16x8*)(ap + k + kk * 32);
#pragma unroll
            for (int n = 0; n < NT; ++n) b[kk][n] = *(const bf16x8*)(bp + (size_t)n * 16 * ldb + k + kk * 32); }
#pragma unroll
        for (int kk = 0; kk < 4; ++kk)
#pragma unroll
            for (int n = 0; n < NT; ++n) acc[n] = __builtin_amdgcn_mfma_f32_16x16x32_bf16(b[kk][n], a[kk], acc[n], 0, 0, 0);
    }
#pragma unroll
    for (int n = 0; n < NT; ++n) store(wid * 16 + fr, n * 16 + 4 * fq, acc[n]);
}

__device__ __forceinline__ void gla_prep_item(const Ptrs& P, int j, int item, LAS unsigned char* lds, int tid) {
    const int h = item & 3, c = (item >> 2) & 31, b = item >> 7;
    const int k = tid & 255, half = tid >> 8, col = h * DK + k;
    const int t0 = b * SEQ + c * CH + half * 32;
    LAS float* tot = (LAS float*)lds;
    float wg[NRANK];
#pragma unroll
    for (int r = 0; r < NRANK; ++r) wg[r] = P.w_gu[(size_t)j * NRANK * KD + (size_t)r * KD + col];
    const float gb = P.gate_bias[(size_t)j * KD + col];
    float bc[32]; float run = 0.f;
#pragma unroll
    for (int t = 0; t < 32; ++t) {
        const float* gl = P.GKL + (size_t)(t0 + t) * NRANK;
        float gsum = gb;
#pragma unroll
        for (int r = 0; r < NRANK; ++r) gsum += gl[r] * wg[r];
        run += logsigmoidf(gsum) * (1.0f / 16.0f);
        bc[t] = run;
    }
    tot[half * 256 + k] = run;
    LDS_WAIT(); __syncthreads();
    const float t_lo = tot[k], t_hi = tot[256 + k];
    const float blast = t_lo + t_hi, add = half ? t_lo : 0.f;
    unsigned kh[16];
    const float qscale = 0.0625f;
#pragma unroll
    for (int t = 0; t < 32; t += 2) {
        float khat[2];
#pragma unroll
        for (int u = 0; u < 2; ++u) {
            const size_t ro = (size_t)(t0 + t + u) * D;
            const float bcv = bc[t + u] + add;
            const float qv = bf2f(P.QK[ro + col]), kv = bf2f(P.QK[ro + KD + col]);
            const float e = expf(bcv);
            P.QT[ro + col] = (bf16)(cvt_pk_bf16(qv * qscale * e, 0.f) & 0xffffu);
            P.QT[ro + KD + col] = (bf16)(cvt_pk_bf16(kv * expf(-bcv), 0.f) & 0xffffu);
            khat[u] = kv * expf(blast - bcv);
        }
        kh[t >> 1] = cvt_pk_bf16(khat[0], khat[1]);
    }
    bf16* kt = P.KT + (size_t)col * MP + t0;
#pragma unroll
    for (int q = 0; q < 4; ++q) { v4u o; o.x = kh[4 * q]; o.y = kh[4 * q + 1]; o.z = kh[4 * q + 2]; o.w = kh[4 * q + 3]; *(v4u*)(kt + 8 * q) = o; }
    if (half == 0) P.DEC[(size_t)(b * NCH + c) * KD + col] = expf(blast);
    __syncthreads();
}

__device__ __forceinline__ void gla_decode_item(const Ptrs& P, int j, int item, LAS unsigned char* lds, int tid) {
    const int h = item & 3, s = item >> 2;
    LAS float* sa = (LAS float*)lds;
    LAS float* sk = sa + 256;
    LAS float* sq = sk + 256;
    LAS float* so = sq + 256;
    LAS float* sr = so + 2048;
    const float* qkv = P.SQKV + (size_t)s * 6144;
    if (tid < 256) {
        const int col = h * DK + tid;
        const float* gl = P.GKL + (size_t)(MP + s) * NRANK;
        float gsum = P.gate_bias[(size_t)j * KD + col];
#pragma unroll
        for (int r = 0; r < NRANK; ++r) gsum += gl[r] * P.w_gu[(size_t)j * NRANK * KD + (size_t)r * KD + col];
        sa[tid] = expf(logsigmoidf(gsum) * (1.0f / 16.0f));
        sk[tid] = qkv[KD + col];
        sq[tid] = qkv[col] * 0.0625f;
    }
    LDS_WAIT(); __syncthreads();
    const int v4 = tid & 127, kq = tid >> 7;
    const f32x4 vv = *(const f32x4*)(qkv + 4096 + h * DV + 4 * v4);
    const size_t sbase = ((size_t)((j * MS + s) * NH + h)) * DK * DV + 4 * v4;
    const float* Sin = P.state_gla + sbase; float* Sout = P.out + O_GS + sbase;
    f32x4 o = (f32x4){0.f, 0.f, 0.f, 0.f};
#pragma unroll 8
    for (int i = 0; i < 64; ++i) { const int kk = kq + 4 * i;
        const f32x4 S = __builtin_nontemporal_load((const f32x4*)(Sin + (size_t)kk * DV));
        const f32x4 Sn = S * sa[kk] + vv * sk[kk];
        __builtin_nontemporal_store(Sn, (f32x4*)(Sout + (size_t)kk * DV));
        o += Sn * sq[kk]; }
    *(LAS f32x4*)(so + kq * 512 + 4 * v4) = o;
    LDS_WAIT(); __syncthreads();
    f32x4 ot = (f32x4){0.f, 0.f, 0.f, 0.f};
    if (tid < 128) {
        ot = *(LAS f32x4*)(so + 4 * tid) + *(LAS f32x4*)(so + 512 + 4 * tid) + *(LAS f32x4*)(so + 1024 + 4 * tid) + *(LAS f32x4*)(so + 1536 + 4 * tid);
        const float ss = wave_sum((ot[0] * ot[0] + ot[1] * ot[1]) + (ot[2] * ot[2] + ot[3] * ot[3]));
        if ((tid & 63) == 0) sr[tid >> 6] = ss;
    }
    LDS_WAIT(); __syncthreads();
    if (tid < 128) {
        const float rstd = 1.0f / sqrtf((sr[0] + sr[1]) * (1.0f / DV) + RMS_EPS);
        const f32x4 nw = *(const f32x4*)(P.norm_w + (size_t)j * DV + 4 * tid);
        const f32x4 og = *(const f32x4*)(qkv + 2048 + h * DV + 4 * tid);
        f32x4 y;
#pragma unroll
        for (int e = 0; e < 4; ++e) y[e] = ot[e] * rstd * nw[e] * (og[e] / (1.0f + expf(-og[e])));
        v2u w; w.x = cvt_pk_bf16(y[0], y[1]); w.y = cvt_pk_bf16(y[2], y[3]);
        *(v2u*)(P.OB + (size_t)(MP + s) * D + h * DV + 4 * tid) = w;
    }
    __syncthreads();
}

__device__ __forceinline__ void gla_scan_item(const Ptrs& P, int j, int u, int wid, int lane) {
    const int bh = u >> 4, tile = u & 15, tdk = tile >> 2, tdv = tile & 3, b = bh >> 2, h = bh & 3;
    const int wdv = wid & 3, wdk = wid >> 2, dv0 = tdv * 128 + wdv * 32, dk0 = tdk * 64 + wdk * 32;
    const int r32 = lane & 31, hi = lane >> 5;
    const bf16* vrow = P.VT + (size_t)(h * DV + dv0 + r32) * MP + b * SEQ + 8 * hi;
    const bf16* krow = P.KT + (size_t)(h * DK + dk0 + r32) * MP + b * SEQ + 8 * hi;
    const float* dec = P.DEC + (size_t)(b * NCH) * KD + h * DK + dk0 + r32;
    f32x16 acc;
#pragma unroll
    for (int r = 0; r < 16; ++r) acc[r] = 0.f;
    for (int c = 0; c < NCH; ++c) {
        bf16* stc = P.ST + ((size_t)(bh * NCH + c) * DV) * DK + dk0 + r32;
        bf16x8 a[4], bb[4];
#pragma unroll
        for (int kk = 0; kk < 4; ++kk) { a[kk] = *(const bf16x8*)(vrow + c * CH + kk * 16); bb[kk] = *(const bf16x8*)(krow + c * CH + kk * 16); }
        const float d = dec[(size_t)c * KD];
#pragma unroll
        for (int r = 0; r < 16; r += 2) { const unsigned w = cvt_pk_bf16(acc[r], acc[r + 1]);
            const int dva = dv0 + (r & 3) + 8 * (r >> 2) + 4 * hi;
            stc[(size_t)dva * DK] = (bf16)(w & 0xffffu); stc[(size_t)(dva + 1) * DK] = (bf16)(w >> 16); }
#pragma unroll
        for (int r = 0; r < 16; ++r) acc[r] *= d;
#pragma unroll
        for (int kk = 0; kk < 4; ++kk) acc = __builtin_amdgcn_mfma_f32_32x32x16_bf16(a[kk], bb[kk], acc, 0, 0, 0);
    }
    float* og = P.out + O_GP + ((size_t)((j * NBAT + b) * NH + h)) * DK * DV + (size_t)(dk0 + r32) * DV + dv0 + 4 * hi;
#pragma unroll
    for (int rg = 0; rg < 4; ++rg) *(f32x4*)(og + 8 * rg) = (f32x4){acc[4 * rg], acc[4 * rg + 1], acc[4 * rg + 2], acc[4 * rg + 3]};
}

__device__ __forceinline__ void gla_out_item(const Ptrs& P, int j, int item, LAS unsigned char* lds, int wid, int lane) {
    const int c = item & 31, bh = item >> 5, b = bh >> 2, h = bh & 3;
    const int t0 = b * SEQ + c * CH;
    const int fr = lane & 15, fq = lane >> 4;
    LAS bf16* attn = (LAS bf16*)lds;
    LAS float* ssq = (LAS float*)(lds + 64 * 72 * 2);
    {
        const int it = wid & 3, jh = wid >> 2;
        f32x4 a2[2] = {(f32x4){0.f, 0.f, 0.f, 0.f}, (f32x4){0.f, 0.f, 0.f, 0.f}};
        const bf16* qrow = P.QT + (size_t)(t0 + 16 * it + fr) * D + h * DK + 8 * fq;
        const bf16* krow0 = P.QT + (size_t)(t0 + 32 * jh + fr) * D + KD + h * DK + 8 * fq;
        const bf16* krow1 = krow0 + (size_t)16 * D;
#pragma unroll
        for (int k = 0; k < DK; k += 32) {
            const bf16x8 qa = *(const bf16x8*)(qrow + k), k0v = *(const bf16x8*)(krow0 + k), k1v = *(const bf16x8*)(krow1 + k);
            a2[0] = __builtin_amdgcn_mfma_f32_16x16x32_bf16(k0v, qa, a2[0], 0, 0, 0);
            a2[1] = __builtin_amdgcn_mfma_f32_16x16x32_bf16(k1v, qa, a2[1], 0, 0, 0);
        }
        const int i = 16 * it + fr;
#pragma unroll
        for (int jj = 0; jj < 2; ++jj) { const int j0 = 32 * jh + 16 * jj + 4 * fq;
            float v[4];
#pragma unroll
            for (int e = 0; e < 4; ++e) v[e] = (j0 + e <= i) ? a2[jj][e] : 0.f;
            v2u w; w.x = cvt_pk_bf16(v[0], v[1]); w.y = cvt_pk_bf16(v[2], v[3]);
            *(LAS v2u*)(attn + i * 72 + j0) = w; }
    }
    LDS_WAIT(); __syncthreads();
    f32x4 acc[4][4];
#pragma unroll
    for (int m = 0; m < 4; ++m)
#pragma unroll
        for (int n = 0; n < 4; ++n) acc[m][n] = (f32x4){0.f, 0.f, 0.f, 0.f};
    {
        const bf16* qrow = P.QT + (size_t)(t0 + fr) * D + h * DK + 8 * fq;
        const bf16* srow = P.ST + ((size_t)(bh * NCH + c) * DV + 64 * wid + fr) * DK + 8 * fq;
#pragma unroll 2
        for (int k = 0; k < DK; k += 32) {
            bf16x8 qa[4], sb[4];
#pragma unroll
            for (int m = 0; m < 4; ++m) qa[m] = *(const bf16x8*)(qrow + (size_t)(16 * m) * D + k);
#pragma unroll
            for (int n = 0; n < 4; ++n) sb[n] = *(const bf16x8*)(srow + (size_t)(16 * n) * DK + k);
#pragma unroll
            for (int m = 0; m < 4; ++m)
#pragma unroll
                for (int n = 0; n < 4; ++n) acc[m][n] = __builtin_amdgcn_mfma_f32_16x16x32_bf16(sb[n], qa[m], acc[m][n], 0, 0, 0);
        }
    }
    {
        const bf16* vrow = P.VT + (size_t)(h * DV + 64 * wid + fr) * MP + t0 + 8 * fq;
#pragma unroll
        for (int k = 0; k < CH; k += 32) {
            bf16x8 pa[4], vb[4];
#pragma unroll
            for (int m = 0; m < 4; ++m) pa[m] = *(const LAS bf16x8*)(attn + (16 * m + fr) * 72 + k + 8 * fq);
#pragma unroll
            for (int n = 0; n < 4; ++n) vb[n] = *(const bf16x8*)(vrow + (size_t)(16 * n) * MP + k);
#pragma unroll
            for (int m = 0; m < 4; ++m)
#pragma unroll
                for (int n = 0; n < 4; ++n) acc[m][n] = __builtin_amdgcn_mfma_f32_16x16x32_bf16(vb[n], pa[m], acc[m][n], 0, 0, 0);
        }
    }
#pragma unroll
    for (int m = 0; m < 4; ++m) { float s = 0.f;
#pragma unroll
        for (int n = 0; n < 4; ++n) s += (acc[m][n][0] * acc[m][n][0] + acc[m][n][1] * acc[m][n][1]) + (acc[m][n][2] * acc[m][n][2] + acc[m][n][3] * acc[m][n][3]);
        s += __shfl_xor(s, 16); s += __shfl_xor(s, 32);
        if (fq == 0) ssq[(16 * m + fr) * 8 + wid] = s; }
    LDS_WAIT(); __syncthreads();
#pragma unroll
    for (int m = 0; m < 4; ++m) {
        const LAS float* sp = ssq + (16 * m + fr) * 8;
        const float tot = ((sp[0] + sp[1]) + (sp[2] + sp[3])) + ((sp[4] + sp[5]) + (sp[6] + sp[7]));
        const float rstd = 1.0f / sqrtf(tot * (1.0f / DV) + RMS_EPS);
        const size_t ro = (size_t)(t0 + 16 * m + fr) * D + h * DV + 64 * wid + 4 * fq;
#pragma unroll
        for (int n = 0; n < 4; ++n) {
            const f32x4 nw = *(const f32x4*)(P.norm_w + (size_t)j * DV + 64 * wid + 16 * n + 4 * fq);
            const v2u ogb = *(const v2u*)(P.OG + ro + 16 * n);
            const float og[4] = {__uint_as_float(ogb.x << 16), __uint_as_float(ogb.x & 0xffff0000u), __uint_as_float(ogb.y << 16), __uint_as_float(ogb.y & 0xffff0000u)};
            float y[4];
#pragma unroll
            for (int e = 0; e < 4; ++e) y[e] = acc[m][n][e] * rstd * nw[e] * (og[e] / (1.0f + expf(-og[e])));
            v2u w; w.x = cvt_pk_bf16(y[0], y[1]); w.y = cvt_pk_bf16(y[2], y[3]);
            *(v2u*)(P.OB + ro + 16 * n) = w; }
    }
    __syncthreads();
}

__global__ void __launch_bounds__(NWAVES * 64, 2) mk_fwd(Args args) {
    extern __shared__ __attribute__((aligned(16))) unsigned char lds_raw[];
    LAS unsigned char* lds = (LAS unsigned char*)lds_raw;
    const int G = gridDim.x, bid = blockIdx.x;
    Ctx C; C.ws = args.ws; C.out = args.out; C.sgla = args.in[3];
    const int lo = args.ph_lo, hi = args.ph_hi;
#define IN(k) (lo <= (k) && (k) < hi)
#if MK_N_LAUNCHES == 1
    volatile LAS unsigned* MISC = (volatile LAS unsigned*)(lds + MISC_OFF);
    if (threadIdx.x < 64) MISC[threadIdx.x] = 0u;
    __syncthreads();
    XcdBarrier bar = xcd_barrier_post((unsigned*)(args.ws + WS_CTL) + CW_BAR, MISC + 8);
#define SEAM(k) do { if (IN(k) && IN((k) + 1)) xcd_barrier(bar); } while (0)
#else
#define SEAM(k) do { } while (0)
#endif
#define PH_IDS const int tid = fresh_tid(), lane = tid & 63, wave = __builtin_amdgcn_readfirstlane(tid >> 6); (void)lane; (void)wave; const Ptrs P = make_ptrs(C)
#define PH_GW const int gw = bid * NWAVES + wave, NGW = G * NWAVES

    if (IN(0)) { prologue_phase(args, lds, bid, G); }
    SEAM(0);

    for (int layer = 0; layer < 4; ++layer) {
        const int jj = layer >> 1;
        const int pb = 1 + jj * 15 + (layer & 1) * 6;
        int pm;
        if ((layer & 1) == 0) {
            if (IN(pb)) { PH_IDS; pool_prep_phase(P, jj, bid, G, tid); }
            SEAM(pb);
            if (IN(pb + 1)) { PH_IDS;
                pg8::Gemm g{P.PB, P.WP + (size_t)jj * 4 * 512 * 512, D, 512, 512, 1, 512 * 2};
                pg8::StaticOrder S; S.init(MP, D, G, bid);
                pg8::EpiF32 E{P.Y32, D};
                pg8::gemm_phase<pg8::EpiF32, pg8::StaticOrder, true>(lds, g, S, E);
                for (int u = bid; u < 64; u += G) {
                    const int gidx = u >> 4, ct = u & 15;
                    float* slab = P.SLAB + gidx * 512 + ct * 32;
                    micro_unit<2>(P.PB + (size_t)MP * D + gidx * 512, D, P.WP + ((size_t)(jj * 4 + gidx) * 512 + ct * 32) * 512, 512, 512, wave, lane,
                        [=](int r, int cc, const f32x4& v) { *(f32x4*)(slab + (size_t)r * D + cc) = v; });
                }
            }
            SEAM(pb + 1);
            if (IN(pb + 2)) { PH_IDS; PH_GW; ln_phase(P, 1, nullptr, P.pool_scale + (size_t)jj * D, P.ln_mix_g + (size_t)layer * D, P.ln_mix_b + (size_t)layer * D, false, gw, NGW, lane); }
            SEAM(pb + 2);
            pm = pb + 3;
        } else {
            if (IN(pb)) { PH_IDS;
                const bf16* win = P.WIN + (size_t)jj * WIN_LAYER;
                {
                    pg8::Gemm g{P.XB, win, D, D, D, 0, 0};
                    pg8::StaticOrder S; S.init(MP, 4096, G, bid);
                    pg8::EpiBf16<0> E{P.QK, D, nullptr, 2048, (size_t)(WS_OG - WS_QK) / 2};
                    pg8::gemm_phase<pg8::EpiBf16<0>, pg8::StaticOrder, true>(lds, g, S, E);
                }
                {
                    pg8::Gemm g{win + (size_t)4096 * D, P.XB, D, D, D, 0, 0};
                    pg8::StaticOrder S; S.init(2048, MP, G, bid);
                    pg8::EpiBf16<0> E{P.VT, MP, nullptr, 0, 0};
                    pg8::gemm_phase<pg8::EpiBf16<0>, pg8::StaticOrder, true>(lds, g, S, E);
                }
                for (int u = bid; u < 192 + 65; u += G) {
                    if (u < 192) {
                        float* o = P.SQKV + u * 32;
                        micro_unit<2>(P.XB + (size_t)MP * D, D, win + (size_t)u * 32 * D, D, D, wave, lane,
                            [=](int r, int cc, const f32x4& v) { *(f32x4*)(o + (size_t)r * 6144 + cc) = v; });
                    } else {
                        const int rb = u - 192;
                        float* o = P.GKL + (size_t)rb * 128 * NRANK;
                        micro_unit<1>(P.XB + (size_t)rb * 128 * D, D, win + (size_t)6144 * D, D, D, wave, lane,
                            [=](int r, int cc, const f32x4& v) { *(f32x4*)(o + (size_t)r * NRANK + cc) = v; });
                    }
                }
            }
            SEAM(pb);
            if (IN(pb + 1)) { PH_IDS;
                for (int it = bid; it < 512; it += G) gla_prep_item(P, jj, it, lds, tid);
                for (int it = bid; it < 512; it += G) gla_decode_item(P, jj, it, lds, tid);
            }
            SEAM(pb + 1);
            if (IN(pb + 2)) { PH_IDS; for (int u = bid; u < 256; u += G) gla_scan_item(P, jj, u, wave, lane); }
            SEAM(pb + 2);
            if (IN(pb + 3)) { PH_IDS; for (int it = bid; it < 512; it += G) gla_out_item(P, jj, it, lds, wave, lane); }
            SEAM(pb + 3);
            if (IN(pb + 4)) { PH_IDS;
                pg8::Gemm g{P.OB, P.WOUT + (size_t)jj * D * D, D, D, D, 0, 0};
                pg8::StaticOrder S; S.init(MP, D, G, bid);
                pg8::EpiF32 E{P.Y32, D};
                pg8::gemm_phase<pg8::EpiF32, pg8::StaticOrder, true>(lds, g, S, E);
                for (int u = bid; u < 256; u += G) {
                    const int ct = u & 63, ks = u >> 6;
                    float* slab = P.SLAB + (size_t)ks * MS * D + ct * 32;
                    micro_unit<2>(P.OB + (size_t)MP * D + ks * 512, D, P.WOUT + (size_t)jj * D * D + (size_t)ct * 32 * D + ks * 512, D, 512, wave, lane,
                        [=](int r, int cc, const f32x4& v) { *(f32x4*)(slab + (size_t)r * D + cc) = v; });
                }
            }
            SEAM(pb + 4);
            if (IN(pb + 5)) { PH_IDS; PH_GW; ln_phase(P, 4, nullptr, nullptr, P.ln_mix_g + (size_t)layer * D, P.ln_mix_b + (size_t)layer * D, false, gw, NGW, lane); }
            SEAM(pb + 5);
            pm = pb + 6;
        }
        if (IN(pm)) { PH_IDS;
            const bf16* w1 = P.W1 + (size_t)layer * D * DFF; const float* b1 = P.b1 + (size_t)layer * DFF;
            pg8::Gemm g{P.XB, w1, D, D, D, 0, 0};
            pg8::StaticOrder S; S.init(MP, DFF, G, bid);
            pg8::EpiBf16<1> E{P.HB, DFF, b1, 0, 0};
            pg8::gemm_phase<pg8::EpiBf16<1>, pg8::StaticOrder, true>(lds, g, S, E);
            for (int u = bid; u < 256; u += G) {
                bf16* o = P.HB + (size_t)MP * DFF + u * 32; const float* bb = b1 + u * 32;
                micro_unit<2>(P.XB + (size_t)MP * D, D, w1 + (size_t)u * 32 * D, D, D, wave, lane,
                    [=](int r, int cc, const f32x4& v) { const f32x4 bv = *(const f32x4*)(bb + cc); float y[4];
#pragma unroll
                        for (int e = 0; e < 4; ++e) { const float a = fmaxf(v[e] + bv[e], 0.f); y[e] = a * a; }
                        v2u w; w.x = cvt_pk_bf16(y[0], y[1]); w.y = cvt_pk_bf16(y[2], y[3]); *(v2u*)(o + (size_t)r * DFF + cc) = w; });
            }
        }
        SEAM(pm);
        if (IN(pm + 1)) { PH_IDS;
            const bf16* w2 = P.W2 + (size_t)layer * DFF * D;
            pg8::Gemm g{P.HB, w2, DFF, DFF, DFF, 0, 0};
            pg8::StaticOrder S; S.init(MP, D, G, bid);
            pg8::EpiF32 E{P.Y32, D};
            pg8::gemm_phase<pg8::EpiF32, pg8::StaticOrder, true>(lds, g, S, E);
            for (int u = bid; u < 256; u += G) {
                const int ct = u & 63, ks = u >> 6;
                float* slab = P.SLAB + (size_t)ks * MS * D + ct * 32;
                micro_unit<2>(P.HB + (size_t)MP * DFF + ks * 2048, DFF, w2 + (size_t)ct * 32 * DFF + ks * 2048, DFF, 2048, wave, lane,
                    [=](int r, int cc, const f32x4& v) { *(f32x4*)(slab + (size_t)r * D + cc) = v; });
            }
        }
        SEAM(pm + 1);
        if (IN(pm + 2)) { PH_IDS; PH_GW; ln_phase(P, 4, P.b2 + (size_t)layer * D, nullptr, P.ln_ffn_g + (size_t)layer * D, P.ln_ffn_b + (size_t)layer * D, layer == 3, gw, NGW, lane); }
        if (layer < 3) SEAM(pm + 2);
    }
#undef IN
#undef SEAM
}

extern "C" void kernel_launch(void* const* d_in, const int* in_sizes, int n_in, void* d_out, int out_size, void* d_ws, size_t ws_size, hipStream_t stream) {
    static int grid = 0;
    if (grid == 0) {
        if (n_in != 19 || (size_t)out_size != O_END || ws_size < WS_END) { fprintf(stderr, "kernel_launch: unexpected shapes: n_in %d out %d ws %zu\n", n_in, out_size, ws_size); grid = -1; return; }
        int dev = 0, cus = 0, per_cu = 0;
        if (hipGetDevice(&dev) != hipSuccess || hipDeviceGetAttribute(&cus, hipDeviceAttributeMultiprocessorCount, dev) != hipSuccess) { grid = -1; return; }
        if (hipFuncSetAttribute((const void*)mk_fwd, hipFuncAttributeMaxDynamicSharedMemorySize, LDS_BYTES) != hipSuccess) { fprintf(stderr, "kernel_launch: hipFuncSetAttribute failed\n"); grid = -1; return; }
        if (hipOccupancyMaxActiveBlocksPerMultiprocessor(&per_cu, (const void*)mk_fwd, NWAVES * 64, LDS_BYTES) != hipSuccess || per_cu < 1)
            fprintf(stderr, "kernel_launch: occupancy query reports %d workgroups per CU\n", per_cu);
        (void)hipGetLastError();
        grid = cus;
    }
    if (grid < 0) return;
    if (hipMemsetAsync((char*)d_ws + WS_CTL, 0, CTL_ZERO_BYTES, stream) != hipSuccess) return;
    Args a{};
    for (int i = 0; i < 19; ++i) a.in[i] = (const float*)d_in[i];
    a.out = (float*)d_out; a.ws = (unsigned char*)d_ws;
    if (MK_N_LAUNCHES == 1) {
        a.ph_lo = 0; a.ph_hi = NPHASE;
        hipLaunchKernelGGL(mk_fwd, dim3(grid), dim3(NWAVES * 64), LDS_BYTES, stream, a);
    } else {
        for (int p = 0; p < NPHASE; ++p) { a.ph_lo = p; a.ph_hi = p + 1;
            hipLaunchKernelGGL(mk_fwd, dim3(grid), dim3(NWAVES * 64), LDS_BYTES, stream, a); }
    }
}
```

```cpp
#include <hip/hip_runtime.h>
#include <cstdio>
#include <cstdint>

#ifndef MK_N_LAUNCHES
#define MK_N_LAUNCHES 1
#endif

#define RP_PRO 1
#define RP_POOL 1
#define RP_MLP 1
#define RP_GLAGEMM 1
#define RP_GLAMIX 1
#define RP_MICRO 1
#define RP_DEC 1
#define GAS __attribute__((address_space(1)))
#define LAS __attribute__((address_space(3)))
typedef unsigned short bf16;
typedef unsigned v4u __attribute__((ext_vector_type(4)));
typedef unsigned v2u __attribute__((ext_vector_type(2)));
typedef float f32x4 __attribute__((ext_vector_type(4)));
typedef float f32x16 __attribute__((ext_vector_type(16)));
typedef short bf16x8 __attribute__((ext_vector_type(8)));

constexpr int D = 2048, MP = 8192, MS = 128, MT = 8320, DFF = 8192, SEQ = 2048, NBAT = 4, NH = 4, DK = 256, DV = 512, KD = 1024;
constexpr int GIN = 6160, NRANK = 16, CH = 64, NCH = 32, PCTX = 15;
constexpr float ALPHA = 1.6817928305074290f;
constexpr float LN_EPS = 1e-5f, RMS_EPS = 1e-5f;
constexpr int NPHASE = 31;
constexpr int NWAVES = 8;

constexpr size_t O_YP = 0, O_YS = 16777216, O_PP = 17039360, O_GP = 17285120, O_PS = 21479424, O_GS = 29343744, O_END = 163561472;

constexpr size_t MiB = 1u << 20;
constexpr size_t WS_CTL = 0, CTL_ZERO_BYTES = 1 * MiB;
constexpr size_t WS_WP = 1 * MiB, WS_WIN = 5 * MiB, WS_WOUT = 54 * MiB, WS_W1 = 70 * MiB, WS_W2 = 198 * MiB;
constexpr size_t WS_X32 = 326 * MiB, WS_XB = 391 * MiB, WS_Y32 = 424 * MiB, WS_PB = 488 * MiB, WS_OB = 521 * MiB, WS_HB = 554 * MiB;
constexpr size_t WS_QK = 684 * MiB, WS_OG = 716 * MiB, WS_VT = 748 * MiB, WS_QT = 780 * MiB, WS_KT = 812 * MiB, WS_ST = 828 * MiB;
constexpr size_t WS_DEC = 956 * MiB, WS_GKL = 957 * MiB, WS_SQKV = 958 * MiB, WS_SLAB = 961 * MiB, WS_PAR = 965 * MiB, WS_WSUM = 966 * MiB, WS_END = 968 * MiB;
constexpr int PAR_PSCALE = 0, PAR_WGU = 4096, PAR_GBIAS = 36864, PAR_NORMW = 38912, PAR_LNMG = 39936, PAR_LNMB = 48128, PAR_B1 = 56320, PAR_B2 = 89088, PAR_LNFG = 97280, PAR_LNFB = 105472, PAR_END = 113664;
constexpr size_t WIN_LAYER = (size_t)GIN * D;
constexpr int CW_BAR = 4096;

constexpr int LDS_BYTES = 147456;
constexpr int MISC_OFF = 147200;

__device__ __forceinline__ unsigned cvt_pk_bf16(float lo, float hi) { unsigned r; asm volatile("v_cvt_pk_bf16_f32 %0, %1, %2" : "=v"(r) : "v"(lo), "v"(hi)); return r; }
__device__ __forceinline__ float bf2f(unsigned short b) { return __uint_as_float(((unsigned)b) << 16); }
__device__ __forceinline__ float wave_sum(float v) {
#pragma unroll
    for (int o = 1; o < 64; o <<= 1) v += __shfl_xor(v, o);
    return v;
}
__device__ __forceinline__ float logsigmoidf(float x) { return fminf(x, 0.f) - log1pf(expf(-fabsf(x))); }
__device__ __forceinline__ int fresh_tid() { int t = threadIdx.x; asm volatile("" : "+v"(t)); return t; }
#define LDS_WAIT() asm volatile("s_waitcnt lgkmcnt(0)" ::: "memory")
#define VM_WAIT() asm volatile("s_waitcnt vmcnt(0)" ::: "memory")

namespace pg8 {
#define PG8_LAS __attribute__((address_space(3)))
typedef unsigned short bf16_t;
typedef unsigned u32x4 __attribute__((ext_vector_type(4)));
constexpr int BM = 256, BK = 64, HALF = 128, HTB = HALF * BK * 2, STAGE_BYTES = 8 * HTB, NXCD = 8, WGM = 8;

__host__ __device__ __forceinline__ int lds_byte(int r, int c) { const int st = (r >> 4) * 2 + (c >> 5), rr = r & 15, cc = c & 31, ob = rr * 64 + cc * 2; return st * 1024 + (ob ^ (((ob >> 9) & 1) << 5)); }
__host__ __device__ __forceinline__ void stage_rc(int b, int& R, int& C) { const int st = b / 1024, sb = b % 1024, swz = sb ^ (((sb >> 9) & 1) << 5); R = (st >> 1) * 16 + swz / 64; C = (st & 1) * 32 + (swz % 64) / 2; }
__host__ __device__ __forceinline__ int perm32(int rho) { const int n = rho >> 4, i = rho & 15; return 8 * (i >> 2) + 4 * n + (i & 3); }

struct Unit { int pm, pn; };
struct Gemm { const bf16_t* A; const bf16_t* Bt; int lda, ldb, K, a_shift, a_step; };

struct StaticOrder {
    int nM, nN, nwg, G, c;
    __host__ __device__ void init(int M, int N, int G_, int c_) { nM = M / BM; nN = N / BM; nwg = nM * nN; G = G_; c = c_; }
    __host__ __device__ bool next(int i, Unit& u) const {
        const long L = (long)i * G + c; if (L >= nwg) return false;
        int wgid = (int)L; { const int q = nwg / NXCD, r = nwg % NXCD, xcd = wgid % NXCD, off = wgid / NXCD; wgid = (xcd < r ? xcd * (q + 1) : r * (q + 1) + (xcd - r) * q) + off; }
        const int nig = WGM * nN, gid = wgid / nig, fm = gid * WGM, gsz = (nM - fm) < WGM ? (nM - fm) : WGM;
        u.pm = fm + ((wgid % nig) % gsz); u.pn = (wgid % nig) / gsz; return true;
    }
    __device__ __forceinline__ void a_ready(const Unit&) const {}
    __device__ __forceinline__ void done(const Unit&) const {}
};

struct EpiF32 {
    static constexpr bool PERM = false, AFTER_DRAIN = false;
    float* C; int ldc;
    __device__ __forceinline__ void operator()(const f32x4 (&acc)[2][2][4][2], const Unit& u, int wr, int wc, int fr, int fq) const {
        const int row0 = u.pm * BM + wr * 64 + fr, col0 = u.pn * BM + wc * 32 + 4 * fq;
#pragma unroll
        for (int ai = 0; ai < 2; ++ai)
#pragma unroll
            for (int m = 0; m < 4; ++m) { float* rowp = C + (size_t)(row0 + ai * HALF + m * 16) * ldc + col0;
#pragma unroll
                for (int bj = 0; bj < 2; ++bj)
#pragma unroll
                    for (int n = 0; n < 2; ++n) *(f32x4*)(rowp + bj * HALF + n * 16) = acc[ai][bj][m][n]; }
    }
};
template <int ACT  > struct EpiBf16 {
    static constexpr bool PERM = true, AFTER_DRAIN = false;
    bf16_t* O; int ldc; const float* bias; int split_cols; size_t split_stride;
    __device__ __forceinline__ void operator()(const f32x4 (&acc)[2][2][4][2], const Unit& u, int wr, int wc, int fr, int fq) const {
        const int row0 = u.pm * BM + wr * 64 + fr; int colt = u.pn * BM; bf16_t* base = O;
        if (split_cols) { const int t = colt / split_cols; base += (size_t)t * split_stride; colt -= t * split_cols; }
        const int col0 = colt + wc * 32 + 8 * fq, bcol0 = u.pn * BM + wc * 32 + 8 * fq;
        f32x4 bv[2][2];
#pragma unroll
        for (int bj = 0; bj < 2; ++bj)
#pragma unroll
            for (int n = 0; n < 2; ++n) bv[bj][n] = bias ? *(const f32x4*)(bias + bcol0 + bj * HALF + 4 * n) : (f32x4){0.f, 0.f, 0.f, 0.f};
#pragma unroll
        for (int ai = 0; ai < 2; ++ai)
#pragma unroll
            for (int m = 0; m < 4; ++m) { bf16_t* rowp = base + (size_t)(row0 + ai * HALF + m * 16) * ldc + col0;
#pragma unroll
                for (int bj = 0; bj < 2; ++bj) { f32x4 v0 = acc[ai][bj][m][0] + bv[bj][0], v1 = acc[ai][bj][m][1] + bv[bj][1];
                    if (ACT == 1) {
#pragma unroll
                        for (int j = 0; j < 4; ++j) { const float a = fmaxf(v0[j], 0.f), b = fmaxf(v1[j], 0.f); v0[j] = a * a; v1[j] = b * b; } }
                    u32x4 w; w.x = cvt_pk_bf16(v0[0], v0[1]); w.y = cvt_pk_bf16(v0[2], v0[3]); w.z = cvt_pk_bf16(v1[0], v1[1]); w.w = cvt_pk_bf16(v1[2], v1[3]);
                    *(u32x4*)(rowp + bj * HALF) = w; } }
    }
};

template <class Epi, class Sched, bool ALIGN_EPI = false>
__device__ __forceinline__ void gemm_phase(PG8_LAS unsigned char* lds, const Gemm g, const Sched& S, const Epi& E) {
    const int tid = fresh_tid(), wid = __builtin_amdgcn_readfirstlane(tid >> 6), lane = tid & 63, wr = wid >> 2, wc = wid & 3, fr = lane & 15, fq = lane >> 4;
    const int K = g.K, nt = K / BK;
    unsigned voffA[2], voffB[2];
#pragma unroll
    for (int i = 0; i < 2; ++i) { int R, C; stage_rc(tid * 16 + i * 8192, R, C); const int Rb = Epi::PERM ? ((R & ~31) + perm32(R & 31)) : R;
        voffA[i] = (unsigned)(R * g.lda + C) * 2u; voffB[i] = (unsigned)(Rb * g.ldb + C) * 2u; }
    const size_t kstep = (size_t)(BK * 2);
    const size_t hstepA = (size_t)HALF * g.lda * 2, hstepB = (size_t)HALF * g.ldb * 2;
    const size_t tstepA = 2 * hstepA, tstepB = 2 * hstepB;
    const unsigned ldsw = (unsigned)wid * 1024u;
    const int aoff = lds_byte(wr * 64 + fr, fq * 8), boff = lds_byte(wc * 32 + fr, fq * 8);
#define PG8_SA(b, h) (((b) * 2 + (h)) * HTB)
#define PG8_SB(b, h) ((4 + (b) * 2 + (h)) * HTB)
#define PG8_STAGE(bufoff, gbase, voff) do { _Pragma("unroll") for (int _i = 0; _i < 2; ++_i) \
        __builtin_amdgcn_global_load_lds((const unsigned*)((const char*)(gbase) + (voff)[_i]), (PG8_LAS unsigned*)(lds + (bufoff) + ldsw + _i * 8192), 16, 0, 0); } while (0)
#define PG8_LDA(dst, b, h) do { _Pragma("unroll") for (int m = 0; m < 4; ++m) _Pragma("unroll") for (int k = 0; k < 2; ++k) dst[m][k] = *(const PG8_LAS bf16x8*)(lds + PG8_SA(b, h) + aoff + m * 2048 + k * 1024); } while (0)
#define PG8_LDB(dst, b, h) do { _Pragma("unroll") for (int n = 0; n < 2; ++n) _Pragma("unroll") for (int k = 0; k < 2; ++k) dst[n][k] = *(const PG8_LAS bf16x8*)(lds + PG8_SB(b, h) + boff + n * 2048 + k * 1024); } while (0)
#define PG8_MMA(ai, bj, At, Bt) do { __builtin_amdgcn_s_setprio(1); _Pragma("unroll") for (int m = 0; m < 4; ++m) _Pragma("unroll") for (int n = 0; n < 2; ++n) _Pragma("unroll") for (int k = 0; k < 2; ++k) \
        acc[ai][bj][m][n] = __builtin_amdgcn_mfma_f32_16x16x32_bf16(Bt[n][k], At[m][k], acc[ai][bj][m][n], 0, 0, 0); __builtin_amdgcn_s_setprio(0); } while (0)
#define PG8_WAIT_V(n) asm volatile("s_waitcnt vmcnt(" #n ")" ::: "memory")
#define PG8_WAIT_L(n) asm volatile("s_waitcnt lgkmcnt(" #n ")" ::: "memory")
#define PG8_BAR __builtin_amdgcn_s_barrier()
#define PG8_SCHED __builtin_amdgcn_sched_barrier(0)
#define PG8_APTR(u) ((const char*)g.A + (size_t)(u).pm * tstepA + (size_t)((u).pn >> g.a_shift) * (size_t)g.a_step)
#define PG8_BPTR(u) ((const char*)g.Bt + (size_t)(u).pn * tstepB)
    Unit cur, nxt; int ui = 0;
    if (!S.next(0, cur)) return;
    f32x4 acc[2][2][4][2];
#pragma unroll
    for (int a = 0; a < 2; ++a)
#pragma unroll
        for (int b = 0; b < 2; ++b)
#pragma unroll
            for (int m = 0; m < 4; ++m)
#pragma unroll
                for (int n = 0; n < 2; ++n) acc[a][b][m][n] = (f32x4){0.f, 0.f, 0.f, 0.f};
    bf16x8 At[4][2], B0[2][2], B1[2][2];
    const char* cA = PG8_APTR(cur); const char* cB = PG8_BPTR(cur);
    S.a_ready(cur);
    PG8_STAGE(PG8_SB(0, 0), cB, voffB); PG8_STAGE(PG8_SB(0, 1), cB + hstepB, voffB); PG8_STAGE(PG8_SA(0, 0), cA, voffA); PG8_STAGE(PG8_SA(0, 1), cA + hstepA, voffA);
    if (wr == 1) PG8_BAR;
    PG8_WAIT_V(2); PG8_BAR;
    PG8_STAGE(PG8_SB(1, 0), cB + kstep, voffB); PG8_STAGE(PG8_SA(1, 0), cA + kstep, voffA); PG8_STAGE(PG8_SB(1, 1), cB + hstepB + kstep, voffB);
    PG8_WAIT_V(6); PG8_BAR;
    for (;;) {
        const bool has_next = S.next(ui + 1, nxt);
        const char* nA = has_next ? PG8_APTR(nxt) : cA; const char* nB = has_next ? PG8_BPTR(nxt) : cB;
        for (int t = 0; t < nt; t += 2) {
            const bool last = (t == nt - 2);
            const char* a1 = cA + (size_t)(t + 1) * kstep;
            const char* a2 = last ? nA : cA + (size_t)(t + 2) * kstep; const char* b2 = last ? nB : cB + (size_t)(t + 2) * kstep;
            const char* a3 = a2 + kstep; const char* b3 = b2 + kstep;
            if (last && has_next) S.a_ready(nxt);
            PG8_LDB(B0, 0, 0); PG8_LDB(B1, 0, 1); PG8_SCHED; PG8_LDA(At, 0, 0); PG8_STAGE(PG8_SA(1, 1), a1 + hstepA, voffA);
            PG8_WAIT_V(8); PG8_WAIT_L(0); PG8_BAR; PG8_MMA(0, 0, At, B0); PG8_MMA(0, 1, At, B1); PG8_BAR; PG8_SCHED;
            PG8_LDA(At, 0, 1); PG8_STAGE(PG8_SB(0, 0), b2, voffB); PG8_STAGE(PG8_SB(0, 1), b2 + hstepB, voffB); PG8_STAGE(PG8_SA(0, 0), a2, voffA);
            PG8_WAIT_V(8); PG8_WAIT_L(0); PG8_BAR; PG8_MMA(1, 0, At, B0); PG8_MMA(1, 1, At, B1); PG8_BAR; PG8_SCHED;
            PG8_LDB(B0, 1, 0); PG8_LDB(B1, 1, 1); PG8_SCHED; PG8_LDA(At, 1, 0); PG8_STAGE(PG8_SA(0, 1), a2 + hstepA, voffA);
            PG8_WAIT_V(8); PG8_WAIT_L(0); PG8_BAR; PG8_MMA(0, 0, At, B0); PG8_MMA(0, 1, At, B1); PG8_BAR; PG8_SCHED;
            PG8_LDA(At, 1, 1); PG8_STAGE(PG8_SB(1, 0), b3, voffB); PG8_STAGE(PG8_SB(1, 1), b3 + hstepB, voffB); PG8_STAGE(PG8_SA(1, 0), a3, voffA);
            PG8_WAIT_V(8); PG8_WAIT_L(0); PG8_BAR; PG8_MMA(1, 0, At, B0); PG8_MMA(1, 1, At, B1); PG8_BAR; PG8_SCHED;
        }
        if constexpr (ALIGN_EPI) { if (wr == 0) PG8_BAR; }
        E(acc, cur, wr, wc, fr, fq); S.done(cur);
        if (!has_next) break;
#pragma unroll
        for (int a = 0; a < 2; ++a)
#pragma unroll
            for (int b = 0; b < 2; ++b)
#pragma unroll
                for (int m = 0; m < 4; ++m)
#pragma unroll
                    for (int n = 0; n < 2; ++n) acc[a][b][m][n] = (f32x4){0.f, 0.f, 0.f, 0.f};
        cur = nxt; cA = nA; cB = nB; ++ui;
        if constexpr (ALIGN_EPI) { if (wr == 1) PG8_BAR; }
    }
    PG8_WAIT_V(0);
    if constexpr (!ALIGN_EPI) { if (wr == 0) PG8_BAR; }
    PG8_BAR;
#undef PG8_SA
#undef PG8_SB
#undef PG8_STAGE
#undef PG8_LDA
#undef PG8_LDB
#undef PG8_MMA
#undef PG8_WAIT_V
#undef PG8_WAIT_L
#undef PG8_BAR
#undef PG8_SCHED
#undef PG8_APTR
#undef PG8_BPTR
}
}

#define XB_TMO      128
#define XB_XCNT(j)  (256  + 64 * (j))
#define XB_XSUB(j)  (1280 + 64 * (j))
#define XB_XGEN(j)  (2304 + 64 * (j))
#define XB_TOP      3328
#define XB_TOPGEN   3392
#define XCD_BAR_WORDS 3456
#define XB_SPIN_CAP (1u << 18)

__device__ __forceinline__ unsigned xb_ld(unsigned* p)              { return __hip_atomic_load(p, __ATOMIC_RELAXED, __HIP_MEMORY_SCOPE_AGENT); }
__device__ __forceinline__ unsigned xb_add(unsigned* p, unsigned v) { return __hip_atomic_fetch_add(p, v, __ATOMIC_RELAXED, __HIP_MEMORY_SCOPE_AGENT); }
__device__ __forceinline__ unsigned xb_xcc_id() { return (unsigned)__builtin_amdgcn_s_getreg((3 << 11) | 20) & 0xFu; }
#define XB_SPIN(cond, bar) do { unsigned _sp = 0; while (cond) { __builtin_amdgcn_s_sleep(1); \
    if ((++_sp & 255u) == 0u) { if (xb_ld(&(bar)[XB_TMO])) break; if (_sp > XB_SPIN_CAP) { atomicAdd(&(bar)[XB_TMO], 1u); break; } } } } while (0)

struct XcdBarrier { unsigned* bar; unsigned x; volatile LAS unsigned* st; };

__device__ __forceinline__ XcdBarrier xcd_barrier_post(unsigned* bar, volatile LAS unsigned* st) {
    XcdBarrier b; b.bar = bar; b.x = xb_xcc_id(); b.st = st;
    if (threadIdx.x == 0) (void)xb_add(&bar[XB_XCNT(b.x)], 1u);
    return b;
}
__device__ __forceinline__ void xcd_barrier_complete(unsigned* bar, unsigned x, unsigned& nloc, unsigned& nx) {
    const unsigned G = gridDim.x * gridDim.y * gridDim.z;
    unsigned sum, cnt, mine, sp = 0u;
    for (;;) {
        sum = 0u; cnt = 0u; mine = 0u;
#pragma unroll
        for (unsigned j = 0; j < 16; ++j) { const unsigned c = xb_ld(&bar[XB_XCNT(j)]); sum += c; cnt += (c > 0u) ? 1u : 0u; mine = (j == x) ? c : mine; }
        if (sum == G) break;
        __builtin_amdgcn_s_sleep(1);
        if ((++sp & 255u) == 0u) { if (xb_ld(&bar[XB_TMO])) break; if (sp > XB_SPIN_CAP) { atomicAdd(&bar[XB_TMO], 1u); break; } }
    }
    nloc = mine > 0u ? mine : 1u; nx = cnt > 0u ? cnt : 1u;
}
__device__ __forceinline__ void xcd_barrier(const XcdBarrier& b) {
    asm volatile("s_waitcnt vmcnt(0)" ::: "memory");
    __syncthreads();
    if (threadIdx.x == 0) {
        unsigned* bar = b.bar;
        __builtin_amdgcn_s_waitcnt(0);
        unsigned nloc = b.st[0], nx = b.st[1];
        if (nloc == 0u) { xcd_barrier_complete(bar, b.x, nloc, nx); b.st[0] = nloc; b.st[1] = nx; }
        const unsigned old = xb_add(&bar[XB_XSUB(b.x)], 1u);
        const unsigned gen = old / nloc;
        if (old + 1u == (gen + 1u) * nloc) {
            __builtin_amdgcn_fence(__ATOMIC_RELEASE, "agent");
            asm volatile("s_waitcnt vmcnt(0)" ::: "memory");
            const unsigned og = xb_add(&bar[XB_TOP], 1u);
            const unsigned tg = og / nx;
            if (og + 1u == (tg + 1u) * nx) xb_add(&bar[XB_TOPGEN], 1u);
            else XB_SPIN(xb_ld(&bar[XB_TOPGEN]) == tg, bar);
            __builtin_amdgcn_fence(__ATOMIC_ACQUIRE, "agent");
            xb_add(&bar[XB_XGEN(b.x)], 1u);
            asm volatile("s_waitcnt vmcnt(0)" ::: "memory");
        } else {
            XB_SPIN(xb_ld(&bar[XB_XGEN(b.x)]) == gen, bar);
            __builtin_amdgcn_fence(__ATOMIC_ACQUIRE, "agent");
            asm volatile("s_waitcnt vmcnt(0)" ::: "memory");
        }
    }
    __syncthreads();
}

__device__ __forceinline__ void tr_item(const float* W, int ldw, int k0, int n0, bf16* WT, int ldk, int drow0, LAS float* scr, int lane) {
    const int lc = lane & 15, lr = lane >> 4;
#pragma unroll 4
    for (int i = 0; i < 16; ++i) {
        const int kk = 4 * i + lr;
        const f32x4 v = *(const f32x4*)(W + (size_t)(k0 + kk) * ldw + n0 + 4 * lc);
        LAS float* s = scr + kk * 65 + 4 * lc;
        s[0] = v[0]; s[1] = v[1]; s[2] = v[2]; s[3] = v[3];
    }
    LDS_WAIT(); asm volatile("" ::: "memory");
    const int c = lane & 7;
#pragma unroll
    for (int j = 0; j < 8; ++j) { const int n = (lane >> 3) + 8 * j; const LAS float* s = scr + (8 * c) * 65 + n;
        v4u o; o.x = cvt_pk_bf16(s[0 * 65], s[1 * 65]); o.y = cvt_pk_bf16(s[2 * 65], s[3 * 65]); o.z = cvt_pk_bf16(s[4 * 65], s[5 * 65]); o.w = cvt_pk_bf16(s[6 * 65], s[7 * 65]);
        *(v4u*)(WT + (size_t)(drow0 + n) * ldk + k0 + 8 * c) = o; }
    LDS_WAIT(); asm volatile("" ::: "memory");
}

struct Ctx { unsigned char* ws; float* out; const float* sgla; };
struct Ptrs {
    const float *state_gla, *pool_scale, *w_gu, *gate_bias, *norm_w, *ln_mix_g, *ln_mix_b, *b1, *b2, *ln_ffn_g, *ln_ffn_b, *WSUM;
    float* out;
    bf16 *WP, *WIN, *WOUT, *W1, *W2, *XB, *PB, *OB, *HB, *QK, *OG, *VT, *QT, *KT, *ST;
    bf16* YB;
    float *DEC, *GKL, *SQKV, *SLAB;
};
__device__ __forceinline__ Ptrs make_ptrs(const Ctx& C) {
    Ptrs P; unsigned char* ws = C.ws; float* par = (float*)(ws + WS_PAR);
    P.state_gla = C.sgla; P.out = C.out;
    P.pool_scale = par + PAR_PSCALE; P.w_gu = par + PAR_WGU; P.gate_bias = par + PAR_GBIAS; P.norm_w = par + PAR_NORMW; P.ln_mix_g = par + PAR_LNMG; P.ln_mix_b = par + PAR_LNMB;
    P.b1 = par + PAR_B1; P.b2 = par + PAR_B2; P.ln_ffn_g = par + PAR_LNFG; P.ln_ffn_b = par + PAR_LNFB; P.WSUM = (const float*)(ws + WS_WSUM);
    P.WP = (bf16*)(ws + WS_WP); P.WIN = (bf16*)(ws + WS_WIN); P.WOUT = (bf16*)(ws + WS_WOUT); P.W1 = (bf16*)(ws + WS_W1); P.W2 = (bf16*)(ws + WS_W2);
    P.XB = (bf16*)(ws + WS_XB); P.PB = (bf16*)(ws + WS_PB); P.OB = (bf16*)(ws + WS_OB); P.HB = (bf16*)(ws + WS_HB);
    P.QK = (bf16*)(ws + WS_QK); P.OG = (bf16*)(ws + WS_OG); P.VT = (bf16*)(ws + WS_VT); P.QT = (bf16*)(ws + WS_QT); P.KT = (bf16*)(ws + WS_KT); P.ST = (bf16*)(ws + WS_ST);
    P.YB = (bf16*)(ws + WS_Y32); P.DEC = (float*)(ws + WS_DEC); P.GKL = (float*)(ws + WS_GKL); P.SQKV = (float*)(ws + WS_SQKV); P.SLAB = (float*)(ws + WS_SLAB);
    return P;
}

struct Args { const float* in[19]; float* out; unsigned char* ws; int ph_lo, ph_hi; };
__device__ __forceinline__ void copy_par(const float* src, float* dst, int n, int gtid, int NGT) { for (int e = gtid; e < n; e += NGT) dst[e] = src[e]; }
__device__ __forceinline__ void prologue_phase(const Args& A, LAS unsigned char* lds, int bid, int G) {
    const int tid = fresh_tid(), lane = tid & 63, wave = __builtin_amdgcn_readfirstlane(tid >> 6);
    const int gw = bid * NWAVES + wave, NGW = G * NWAVES, gtid = bid * (NWAVES * 64) + tid, NGT = G * NWAVES * 64;
    unsigned char* ws = A.ws;
    const float *xp = A.in[0], *xs = A.in[1], *state_pool = A.in[2], *pool_w = A.in[4], *w_in = A.in[6], *w_out = A.in[10], *w1 = A.in[13], *w2 = A.in[15];
    bf16 *WP = (bf16*)(ws + WS_WP), *WIN = (bf16*)(ws + WS_WIN), *WOUT = (bf16*)(ws + WS_WOUT), *W1 = (bf16*)(ws + WS_W1), *W2 = (bf16*)(ws + WS_W2);
    LAS float* scr = (LAS float*)(lds + wave * 16640);
    constexpr int T_POOL = 8 * 64, T_IN = 2 * 32 * 96, T_OUT = 2 * 32 * 32, T_1 = 4 * 32 * 128, T_2 = 4 * 128 * 32;
    constexpr int NT = T_POOL + T_IN + T_OUT + T_1 + T_2;
    for (int it = gw; it < NT; it += NGW) {
        int r = it;
        if (r < T_POOL) { const int mtx = r >> 6, t = r & 63, kb = t >> 3, nb = t & 7;
            tr_item(pool_w + (size_t)mtx * 512 * 512, 512, kb * 64, nb * 64, WP + (size_t)mtx * 512 * 512, 512, nb * 64, scr, lane); continue; }
        r -= T_POOL;
        if (r < T_IN) { const int l = r / (32 * 96), t = r % (32 * 96), kb = t / 96, nb = t % 96; const int n0 = nb * 64;
            const int drow = n0 < 2048 ? n0 : (n0 < 4096 ? n0 + 2048 : n0 - 2048);
            tr_item(w_in + (size_t)l * D * GIN, GIN, kb * 64, n0, WIN + (size_t)l * WIN_LAYER, D, drow, scr, lane); continue; }
        r -= T_IN;
        if (r < T_OUT) { const int l = r >> 10, t = r & 1023, kb = t >> 5, nb = t & 31;
            tr_item(w_out + (size_t)l * D * D, D, kb * 64, nb * 64, WOUT + (size_t)l * D * D, D, nb * 64, scr, lane); continue; }
        r -= T_OUT;
        if (r < T_1) { const int l = r >> 12, t = r & 4095, kb = t >> 7, nb = t & 127;
            tr_item(w1 + (size_t)l * D * DFF, DFF, kb * 64, nb * 64, W1 + (size_t)l * D * DFF, D, nb * 64, scr, lane); continue; }
        r -= T_1;
        { const int l = r >> 12, t = r & 4095, kb = t >> 5, nb = t & 31;
            tr_item(w2 + (size_t)l * DFF * D, D, kb * 64, nb * 64, W2 + (size_t)l * DFF * D, DFF, nb * 64, scr, lane); }
    }
    for (int e = gtid; e < 2 * NRANK * D; e += NGT) { const int l = e / (NRANK * D), rem = e % (NRANK * D), n = rem / D, k = rem % D;
        const float v = w_in[(size_t)l * D * GIN + (size_t)k * GIN + 6144 + n];
        WIN[(size_t)l * WIN_LAYER + (size_t)(6144 + n) * D + k] = (bf16)(cvt_pk_bf16(v, 0.f) & 0xffffu); }
    bf16* XB = (bf16*)(ws + WS_XB);
    for (int e = gtid; e < MT * D / 4; e += NGT) {
        const size_t o = (size_t)e * 4; const int r = (int)(o / D), c = (int)(o % D);
        const f32x4 v = r < MP ? *(const f32x4*)(xp + o) : *(const f32x4*)(xs + (o - (size_t)MP * D));
        v2u w; w.x = cvt_pk_bf16(v[0], v[1]); w.y = cvt_pk_bf16(v[2], v[3]); *(v2u*)(XB + o) = w;
        if (r < MP) { const int b = r / SEQ, l = r % SEQ; if (l >= SEQ - PCTX) *(f32x4*)(A.out + O_PP + ((size_t)b * PCTX + (l - (SEQ - PCTX))) * D + c) = v; }
        else *(f32x4*)(A.out + O_PS + ((size_t)(r - MP) * PCTX + (PCTX - 1)) * D + c) = v;
    }
    float* par = (float*)(ws + WS_PAR);
    copy_par(A.in[5], par + PAR_PSCALE, 2 * D, gtid, NGT);           copy_par(A.in[7], par + PAR_WGU, 2 * NRANK * KD, gtid, NGT);
    copy_par(A.in[8], par + PAR_GBIAS, 2 * KD, gtid, NGT);           copy_par(A.in[9], par + PAR_NORMW, 2 * DV, gtid, NGT);
    copy_par(A.in[11], par + PAR_LNMG, 4 * D, gtid, NGT);            copy_par(A.in[12], par + PAR_LNMB, 4 * D, gtid, NGT);
    copy_par(A.in[14], par + PAR_B1, 4 * DFF, gtid, NGT);            copy_par(A.in[16], par + PAR_B2, 4 * D, gtid, NGT);
    copy_par(A.in[17], par + PAR_LNFG, 4 * D, gtid, NGT);            copy_par(A.in[18], par + PAR_LNFB, 4 * D, gtid, NGT);
    float* WSUM = (float*)(ws + WS_WSUM);
    for (int e = gtid; e < 2 * MS * (D / 4); e += NGT) {
        const int c = (e % (D / 4)) * 4, js = e / (D / 4);
        const int w = 2 << (c >> 9);
        const float* ctx = state_pool + (size_t)js * PCTX * D + c;
        float* octx = A.out + O_PS + (size_t)js * PCTX * D + c;
        f32x4 s = (f32x4){0.f, 0.f, 0.f, 0.f};
        for (int i = 0; i < PCTX; ++i) { const f32x4 cv = *(const f32x4*)(ctx + (size_t)i * D);
            if (i >= PCTX - (w - 1)) s += cv;
            if (i >= 1) *(f32x4*)(octx + (size_t)(i - 1) * D) = cv; }
        *(f32x4*)(WSUM + (size_t)js * D + c) = s;
    }
}

__device__ __forceinline__ void unpack8(const v4u w, float (&f)[8]) {
    f[0] = __uint_as_float(w.x << 16); f[1] = __uint_as_float(w.x & 0xffff0000u); f[2] = __uint_as_float(w.y << 16); f[3] = __uint_as_float(w.y & 0xffff0000u);
    f[4] = __uint_as_float(w.z << 16); f[5] = __uint_as_float(w.z & 0xffff0000u); f[6] = __uint_as_float(w.w << 16); f[7] = __uint_as_float(w.w & 0xffff0000u);
}
__device__ __forceinline__ void ln_phase(const Ptrs& P, int nsplit, const float* bias, const float* scale, const float* gam, const float* bet, bool last, int gw, int NGW, int lane) {
    for (int r = gw; r < MT; r += NGW) {
        float v[4][8];
        const bf16* xr = P.XB + (size_t)r * D;
        if (r < MP) { const bf16* yr = P.YB + (size_t)r * D;
#pragma unroll
            for (int j = 0; j < 4; ++j) unpack8(*(const v4u*)(yr + 8 * lane + 512 * j), v[j]);
        } else {
#pragma unroll
            for (int j = 0; j < 4; ++j)
#pragma unroll
                for (int e = 0; e < 8; ++e) v[j][e] = 0.f;
            for (int s = 0; s < nsplit; ++s) { const float* yr = P.SLAB + ((size_t)s * MS + (r - MP)) * D;
#pragma unroll
                for (int j = 0; j < 4; ++j) { const f32x4 a = *(const f32x4*)(yr + 8 * lane + 512 * j), b = *(const f32x4*)(yr + 8 * lane + 512 * j + 4);
#pragma unroll
                    for (int e = 0; e < 4; ++e) { v[j][e] += a[e]; v[j][4 + e] += b[e]; } } }
        }
        float sum = 0.f;
#pragma unroll
        for (int j = 0; j < 4; ++j) { const int c = 8 * lane + 512 * j;
            float xv[8]; unpack8(*(const v4u*)(xr + c), xv);
            if (bias) { const f32x4 a = *(const f32x4*)(bias + c), b = *(const f32x4*)(bias + c + 4);
#pragma unroll
                for (int e = 0; e < 4; ++e) { v[j][e] += a[e]; v[j][4 + e] += b[e]; } }
            if (scale) { const f32x4 a = *(const f32x4*)(scale + c), b = *(const f32x4*)(scale + c + 4);
#pragma unroll
                for (int e = 0; e < 4; ++e) { v[j][e] *= a[e]; v[j][4 + e] *= b[e]; } }
#pragma unroll
            for (int e = 0; e < 8; ++e) { v[j][e] += ALPHA * xv[e]; sum += v[j][e]; } }
        const float mean = wave_sum(sum) * (1.f / D); float s2 = 0.f;
#pragma unroll
        for (int j = 0; j < 4; ++j)
#pragma unroll
            for (int e = 0; e < 8; ++e) { v[j][e] -= mean; s2 += v[j][e] * v[j][e]; }
        const float rstd = 1.0f / sqrtf(wave_sum(s2) * (1.f / D) + LN_EPS);
        float* o32 = r < MP ? P.out + O_YP + (size_t)r * D : P.out + O_YS + (size_t)(r - MP) * D;
        bf16* ob = P.XB + (size_t)r * D;
#pragma unroll
        for (int j = 0; j < 4; ++j) { const int c = 8 * lane + 512 * j;
            const f32x4 ga = *(const f32x4*)(gam + c), gb = *(const f32x4*)(gam + c + 4), ba = *(const f32x4*)(bet + c), bb = *(const f32x4*)(bet + c + 4);
            float y[8];
#pragma unroll
            for (int e = 0; e < 4; ++e) { y[e] = v[j][e] * rstd * ga[e] + ba[e]; y[4 + e] = v[j][4 + e] * rstd * gb[e] + bb[e]; }
            if (last) { *(f32x4*)(o32 + c) = (f32x4){y[0], y[1], y[2], y[3]}; *(f32x4*)(o32 + c + 4) = (f32x4){y[4], y[5], y[6], y[7]}; }
            else { v4u w; w.x = cvt_pk_bf16(y[0], y[1]); w.y = cvt_pk_bf16(y[2], y[3]); w.z = cvt_pk_bf16(y[4], y[5]); w.w = cvt_pk_bf16(y[6], y[7]); *(v4u*)(ob + c) = w; } }
    }
}

__device__ __forceinline__ f32x4 ld4bf(const bf16* p) { const v2u w = *(const v2u*)p; return (f32x4){__uint_as_float(w.x << 16), __uint_as_float(w.x & 0xffff0000u), __uint_as_float(w.y << 16), __uint_as_float(w.y & 0xffff0000u)}; }
__device__ __forceinline__ void pool_prep_phase(const Ptrs& P, int j, int bid, int G, int tid) {
    const int c = tid * 4, g = tid >> 7, w = 2 << g;
    const bf16* X = P.XB;
    for (int blk = bid; blk < MP / 32; blk += G) {
        const int r0 = blk * 32, b = r0 / SEQ, l0 = r0 % SEQ;
        f32x4 s = (f32x4){0.f, 0.f, 0.f, 0.f};
        for (int i = 1; i < w; ++i) { const int l = l0 - i; if (l >= 0) s += ld4bf(X + (size_t)(b * SEQ + l) * D + c); }
        for (int t = 0; t < 32; ++t) {
            const int l = l0 + t; const size_t ro = (size_t)(r0 + t) * D + c;
            const f32x4 xv = ld4bf(X + ro);
            s += xv;
            const float inv = 1.0f / (float)(l + 1 < w ? l + 1 : w);
            const f32x4 p = s * inv - xv;
            v2u o; o.x = cvt_pk_bf16(p[0], p[1]); o.y = cvt_pk_bf16(p[2], p[3]); *(v2u*)(P.PB + ro) = o;
            const int lo = l - w + 1; if (lo >= 0) s -= ld4bf(X + (size_t)(b * SEQ + lo) * D + c);
            if (j > 0 && l >= SEQ - PCTX) *(f32x4*)(P.out + O_PP + ((size_t)(j * NBAT + b) * PCTX + (l - (SEQ - PCTX))) * D + c) = xv;
        }
    }
    for (int sidx = bid; sidx < MS; sidx += G) {
        const size_t ro = (size_t)(MP + sidx) * D + c;
        const f32x4 xv = ld4bf(X + ro);
        const f32x4 s = xv + *(const f32x4*)(P.WSUM + (size_t)(j * MS + sidx) * D + c);
        if (j > 0) *(f32x4*)(P.out + O_PS + ((size_t)(j * MS + sidx) * PCTX + (PCTX - 1)) * D + c) = xv;
        const f32x4 p = s * (1.0f / (float)w) - xv;
        v2u o; o.x = cvt_pk_bf16(p[0], p[1]); o.y = cvt_pk_bf16(p[2], p[3]); *(v2u*)(P.PB + ro) = o;
    }
}

template <int NT, class F>
__device__ __forceinline__ void micro_unit(const bf16* A, int lda, const bf16* Bt, int ldb, int Kc, LAS unsigned char* lds, int tid, int wid, int lane, const F& store) {
    constexpr int PITCH = 16 * NT + 4, WSZ = 128 * PITCH;
    const int fr = lane & 15, fq = lane >> 4, kw = Kc >> 3;
    const bf16* ap = A + (size_t)fr * lda + wid * kw + fq * 8;
    const bf16* bp = Bt + (size_t)fr * ldb + wid * kw + fq * 8;
    f32x4 acc[8][NT];
#pragma unroll
    for (int m = 0; m < 8; ++m)
#pragma unroll
        for (int n = 0; n < NT; ++n) acc[m][n] = (f32x4){0.f, 0.f, 0.f, 0.f};
    for (int k = 0; k < kw; k += 64) {
        bf16x8 a[2][8], b[2][NT];
#pragma unroll
        for (int kk = 0; kk < 2; ++kk) {
#pragma unroll
            for (int m = 0; m < 8; ++m) a[kk][m] = *(const bf16x8*)(ap + (size_t)(16 * m) * lda + k + kk * 32);
#pragma unroll
            for (int n = 0; n < NT; ++n) b[kk][n] = *(const bf16x8*)(bp + (size_t)(16 * n) * ldb + k + kk * 32); }
#pragma unroll
        for (int kk = 0; kk < 2; ++kk)
#pragma unroll
            for (int m = 0; m < 8; ++m)
#pragma unroll
                for (int n = 0; n < NT; ++n) acc[m][n] = __builtin_amdgcn_mfma_f32_16x16x32_bf16(b[kk][n], a[kk][m], acc[m][n], 0, 0, 0);
    }
    LAS float* part = (LAS float*)lds + (wid & 3) * WSZ + fr * PITCH + 4 * fq;
    if (wid >= 4) {
#pragma unroll
        for (int m = 0; m < 8; ++m)
#pragma unroll
            for (int n = 0; n < NT; ++n) *(LAS f32x4*)(part + 16 * m * PITCH + 16 * n) = acc[m][n];
    }
    LDS_WAIT(); __syncthreads();
    if (wid < 4) {
#pragma unroll
        for (int m = 0; m < 8; ++m)
#pragma unroll
            for (int n = 0; n < NT; ++n) { acc[m][n] += *(LAS f32x4*)(part + 16 * m * PITCH + 16 * n); }
    }
    LDS_WAIT(); __syncthreads();
    if (wid < 4) {
#pragma unroll
        for (int m = 0; m < 8; ++m)
#pragma unroll
            for (int n = 0; n < NT; ++n) *(LAS f32x4*)(part + 16 * m * PITCH + 16 * n) = acc[m][n];
    }
    LDS_WAIT(); __syncthreads();
#pragma unroll
    for (int i = 0; i < NT; ++i) { const int idx = tid + 512 * i, row = idx / (4 * NT), c4 = (idx % (4 * NT)) * 4;
        const LAS float* q = (const LAS float*)lds + row * PITCH + c4;
        const f32x4 sum = (*(const LAS f32x4*)q + *(const LAS f32x4*)(q + WSZ)) + (*(const LAS f32x4*)(q + 2 * WSZ) + *(const LAS f32x4*)(q + 3 * WSZ));
        store(row, c4, sum); }
    __syncthreads();
}

__device__ __forceinline__ void gla_prep_item(const Ptrs& P, int j, int item, LAS unsigned char* lds, int tid) {
    const int h = item & 3, c = (item >> 2) & 31, b = item >> 7;
    const int k = tid & 255, half = tid >> 8, col = h * DK + k;
    const int t0 = b * SEQ + c * CH + half * 32;
    LAS float* tot = (LAS float*)lds;
    float wg[NRANK];
#pragma unroll
    for (int r = 0; r < NRANK; ++r) wg[r] = P.w_gu[(size_t)j * NRANK * KD + (size_t)r * KD + col];
    const float gb = P.gate_bias[(size_t)j * KD + col];
    float bc[32]; float run = 0.f;
#pragma unroll
    for (int t = 0; t < 32; ++t) {
        const float* gl = P.GKL + (size_t)(t0 + t) * NRANK;
        float gsum = gb;
#pragma unroll
        for (int r = 0; r < NRANK; ++r) gsum += gl[r] * wg[r];
        run += logsigmoidf(gsum) * (1.0f / 16.0f);
        bc[t] = run;
    }
    tot[half * 256 + k] = run;
    LDS_WAIT(); __syncthreads();
    const float t_lo = tot[k], t_hi = tot[256 + k];
    const float blast = t_lo + t_hi, add = half ? t_lo : 0.f;
    unsigned kh[16];
    const float qscale = 0.0625f;
#pragma unroll
    for (int t = 0; t < 32; t += 2) {
        float khat[2];
#pragma unroll
        for (int u = 0; u < 2; ++u) {
            const size_t ro = (size_t)(t0 + t + u) * D;
            const float bcv = bc[t + u] + add;
            const float qv = bf2f(P.QK[ro + col]), kv = bf2f(P.QK[ro + KD + col]);
            const float e = expf(bcv);
            P.QT[ro + col] = (bf16)(cvt_pk_bf16(qv * qscale * e, 0.f) & 0xffffu);
            P.QT[ro + KD + col] = (bf16)(cvt_pk_bf16(kv * expf(-bcv), 0.f) & 0xffffu);
            khat[u] = kv * expf(blast - bcv);
        }
        kh[t >> 1] = cvt_pk_bf16(khat[0], khat[1]);
    }
    bf16* kt = P.KT + (size_t)col * MP + t0;
#pragma unroll
    for (int q = 0; q < 4; ++q) { v4u o; o.x = kh[4 * q]; o.y = kh[4 * q + 1]; o.z = kh[4 * q + 2]; o.w = kh[4 * q + 3]; *(v4u*)(kt + 8 * q) = o; }
    if (half == 0) P.DEC[(size_t)(b * NCH + c) * KD + col] = expf(blast);
    __syncthreads();
}

__device__ __forceinline__ void gla_decode_item(const Ptrs& P, int j, int item, LAS unsigned char* lds, int tid) {
    const int h = item & 3, s = item >> 2;
    LAS float* sa = (LAS float*)lds;
    LAS float* sk = sa + 256;
    LAS float* sq = sk + 256;
    LAS float* so = sq + 256;
    LAS float* sr = so + 2048;
    const float* qkv = P.SQKV + (size_t)s * 6144;
    if (tid < 256) {
        const int col = h * DK + tid;
        const float* gl = P.GKL + (size_t)(MP + s) * NRANK;
        float gsum = P.gate_bias[(size_t)j * KD + col];
#pragma unroll
        for (int r = 0; r < NRANK; ++r) gsum += gl[r] * P.w_gu[(size_t)j * NRANK * KD + (size_t)r * KD + col];
        sa[tid] = expf(logsigmoidf(gsum) * (1.0f / 16.0f));
        sk[tid] = qkv[KD + col];
        sq[tid] = qkv[col] * 0.0625f;
    }
    LDS_WAIT(); __syncthreads();
    const int v4 = tid & 127, kq = tid >> 7;
    const f32x4 vv = *(const f32x4*)(qkv + 4096 + h * DV + 4 * v4);
    const size_t sbase = ((size_t)((j * MS + s) * NH + h)) * DK * DV + 4 * v4;
    const float* Sin = P.state_gla + sbase; float* Sout = P.out + O_GS + sbase;
    f32x4 o = (f32x4){0.f, 0.f, 0.f, 0.f};
#pragma unroll 8
    for (int i = 0; i < 64; ++i) { const int kk = kq + 4 * i;
        const f32x4 S = __builtin_nontemporal_load((const f32x4*)(Sin + (size_t)kk * DV));
        const f32x4 Sn = S * sa[kk] + vv * sk[kk];
        __builtin_nontemporal_store(Sn, (f32x4*)(Sout + (size_t)kk * DV));
        o += Sn * sq[kk]; }
    *(LAS f32x4*)(so + kq * 512 + 4 * v4) = o;
    LDS_WAIT(); __syncthreads();
    f32x4 ot = (f32x4){0.f, 0.f, 0.f, 0.f};
    if (tid < 128) {
        ot = *(LAS f32x4*)(so + 4 * tid) + *(LAS f32x4*)(so + 512 + 4 * tid) + *(LAS f32x4*)(so + 1024 + 4 * tid) + *(LAS f32x4*)(so + 1536 + 4 * tid);
        const float ss = wave_sum((ot[0] * ot[0] + ot[1] * ot[1]) + (ot[2] * ot[2] + ot[3] * ot[3]));
        if ((tid & 63) == 0) sr[tid >> 6] = ss;
    }
    LDS_WAIT(); __syncthreads();
    if (tid < 128) {
        const float rstd = 1.0f / sqrtf((sr[0] + sr[1]) * (1.0f / DV) + RMS_EPS);
        const f32x4 nw = *(const f32x4*)(P.norm_w + (size_t)j * DV + 4 * tid);
        const f32x4 og = *(const f32x4*)(qkv + 2048 + h * DV + 4 * tid);
        f32x4 y;
#pragma unroll
        for (int e = 0; e < 4; ++e) y[e] = ot[e] * rstd * nw[e] * (og[e] / (1.0f + expf(-og[e])));
        v2u w; w.x = cvt_pk_bf16(y[0], y[1]); w.y = cvt_pk_bf16(y[2], y[3]);
        *(v2u*)(P.OB + (size_t)(MP + s) * D + h * DV + 4 * tid) = w;
    }
    __syncthreads();
}

__device__ __forceinline__ void gla_scan_item(const Ptrs& P, int j, int u, int wid, int lane) {
    const int bh = u >> 4, tile = u & 15, tdk = tile >> 2, tdv = tile & 3, b = bh >> 2, h = bh & 3;
    const int wdv = wid & 3, wdk = wid >> 2, dv0 = tdv * 128 + wdv * 32, dk0 = tdk * 64 + wdk * 32;
    const int r32 = lane & 31, hi = lane >> 5;
    const bf16* vrow = P.VT + (size_t)(h * DV + dv0 + r32) * MP + b * SEQ + 8 * hi;
    const bf16* krow = P.KT + (size_t)(h * DK + dk0 + r32) * MP + b * SEQ + 8 * hi;
    const float* dec = P.DEC + (size_t)(b * NCH) * KD + h * DK + dk0 + r32;
    f32x16 acc;
#pragma unroll
    for (int r = 0; r < 16; ++r) acc[r] = 0.f;
    for (int c = 0; c < NCH; ++c) {
        bf16* stc = P.ST + ((size_t)(bh * NCH + c) * DV) * DK + dk0 + r32;
        bf16x8 a[4], bb[4];
#pragma unroll
        for (int kk = 0; kk < 4; ++kk) { a[kk] = *(const bf16x8*)(vrow + c * CH + kk * 16); bb[kk] = *(const bf16x8*)(krow + c * CH + kk * 16); }
        const float d = dec[(size_t)c * KD];
#pragma unroll
        for (int r = 0; r < 16; r += 2) { const unsigned w = cvt_pk_bf16(acc[r], acc[r + 1]);
            const int dva = dv0 + (r & 3) + 8 * (r >> 2) + 4 * hi;
            stc[(size_t)dva * DK] = (bf16)(w & 0xffffu); stc[(size_t)(dva + 1) * DK] = (bf16)(w >> 16); }
#pragma unroll
        for (int r = 0; r < 16; ++r) acc[r] *= d;
#pragma unroll
        for (int kk = 0; kk < 4; ++kk) acc = __builtin_amdgcn_mfma_f32_32x32x16_bf16(a[kk], bb[kk], acc, 0, 0, 0);
    }
    float* og = P.out + O_GP + ((size_t)((j * NBAT + b) * NH + h)) * DK * DV + (size_t)(dk0 + r32) * DV + dv0 + 4 * hi;
#pragma unroll
    for (int rg = 0; rg < 4; ++rg) *(f32x4*)(og + 8 * rg) = (f32x4){acc[4 * rg], acc[4 * rg + 1], acc[4 * rg + 2], acc[4 * rg + 3]};
}

__device__ __forceinline__ void gla_out_item(const Ptrs& P, int j, int item, LAS unsigned char* lds, int wid, int lane) {
    const int c = item & 31, bh = item >> 5, b = bh >> 2, h = bh & 3;
    const int t0 = b * SEQ + c * CH;
    const int fr = lane & 15, fq = lane >> 4;
    LAS bf16* attn = (LAS bf16*)lds;
    LAS float* ssq = (LAS float*)(lds + 64 * 72 * 2);
    {
        const int it = wid & 3, jh = wid >> 2;
        f32x4 a2[2] = {(f32x4){0.f, 0.f, 0.f, 0.f}, (f32x4){0.f, 0.f, 0.f, 0.f}};
        const bf16* qrow = P.QT + (size_t)(t0 + 16 * it + fr) * D + h * DK + 8 * fq;
        const bf16* krow0 = P.QT + (size_t)(t0 + 32 * jh + fr) * D + KD + h * DK + 8 * fq;
        const bf16* krow1 = krow0 + (size_t)16 * D;
#pragma unroll
        for (int k = 0; k < DK; k += 32) {
            const bf16x8 qa = *(const bf16x8*)(qrow + k), k0v = *(const bf16x8*)(krow0 + k), k1v = *(const bf16x8*)(krow1 + k);
            a2[0] = __builtin_amdgcn_mfma_f32_16x16x32_bf16(k0v, qa, a2[0], 0, 0, 0);
            a2[1] = __builtin_amdgcn_mfma_f32_16x16x32_bf16(k1v, qa, a2[1], 0, 0, 0);
        }
        const int i = 16 * it + fr;
#pragma unroll
        for (int jj = 0; jj < 2; ++jj) { const int j0 = 32 * jh + 16 * jj + 4 * fq;
            float v[4];
#pragma unroll
            for (int e = 0; e < 4; ++e) v[e] = (j0 + e <= i) ? a2[jj][e] : 0.f;
            v2u w; w.x = cvt_pk_bf16(v[0], v[1]); w.y = cvt_pk_bf16(v[2], v[3]);
            *(LAS v2u*)(attn + i * 72 + j0) = w; }
    }
    LDS_WAIT(); __syncthreads();
    f32x4 acc[4][4];
#pragma unroll
    for (int m = 0; m < 4; ++m)
#pragma unroll
        for (int n = 0; n < 4; ++n) acc[m][n] = (f32x4){0.f, 0.f, 0.f, 0.f};
    {
        const bf16* qrow = P.QT + (size_t)(t0 + fr) * D + h * DK + 8 * fq;
        const bf16* srow = P.ST + ((size_t)(bh * NCH + c) * DV + 64 * wid + fr) * DK + 8 * fq;
#pragma unroll 2
        for (int k = 0; k < DK; k += 32) {
            bf16x8 qa[4], sb[4];
#pragma unroll
            for (int m = 0; m < 4; ++m) qa[m] = *(const bf16x8*)(qrow + (size_t)(16 * m) * D + k);
#pragma unroll
            for (int n = 0; n < 4; ++n) sb[n] = *(const bf16x8*)(srow + (size_t)(16 * n) * DK + k);
#pragma unroll
            for (int m = 0; m < 4; ++m)
#pragma unroll
                for (int n = 0; n < 4; ++n) acc[m][n] = __builtin_amdgcn_mfma_f32_16x16x32_bf16(sb[n], qa[m], acc[m][n], 0, 0, 0);
        }
    }
    {
        const bf16* vrow = P.VT + (size_t)(h * DV + 64 * wid + fr) * MP + t0 + 8 * fq;
#pragma unroll
        for (int k = 0; k < CH; k += 32) {
            bf16x8 pa[4], vb[4];
#pragma unroll
            for (int m = 0; m < 4; ++m) pa[m] = *(const LAS bf16x8*)(attn + (16 * m + fr) * 72 + k + 8 * fq);
#pragma unroll
            for (int n = 0; n < 4; ++n) vb[n] = *(const bf16x8*)(vrow + (size_t)(16 * n) * MP + k);
#pragma unroll
            for (int m = 0; m < 4; ++m)
#pragma unroll
                for (int n = 0; n < 4; ++n) acc[m][n] = __builtin_amdgcn_mfma_f32_16x16x32_bf16(vb[n], pa[m], acc[m][n], 0, 0, 0);
        }
    }
#pragma unroll
    for (int m = 0; m < 4; ++m) { float s = 0.f;
#pragma unroll
        for (int n = 0; n < 4; ++n) s += (acc[m][n][0] * acc[m][n][0] + acc[m][n][1] * acc[m][n][1]) + (acc[m][n][2] * acc[m][n][2] + acc[m][n][3] * acc[m][n][3]);
        s += __shfl_xor(s, 16); s += __shfl_xor(s, 32);
        if (fq == 0) ssq[(16 * m + fr) * 8 + wid] = s; }
    LDS_WAIT(); __syncthreads();
#pragma unroll
    for (int m = 0; m < 4; ++m) {
        const LAS float* sp = ssq + (16 * m + fr) * 8;
        const float tot = ((sp[0] + sp[1]) + (sp[2] + sp[3])) + ((sp[4] + sp[5]) + (sp[6] + sp[7]));
        const float rstd = 1.0f / sqrtf(tot * (1.0f / DV) + RMS_EPS);
        const size_t ro = (size_t)(t0 + 16 * m + fr) * D + h * DV + 64 * wid + 4 * fq;
#pragma unroll
        for (int n = 0; n < 4; ++n) {
            const f32x4 nw = *(const f32x4*)(P.norm_w + (size_t)j * DV + 64 * wid + 16 * n + 4 * fq);
            const v2u ogb = *(const v2u*)(P.OG + ro + 16 * n);
            const float og[4] = {__uint_as_float(ogb.x << 16), __uint_as_float(ogb.x & 0xffff0000u), __uint_as_float(ogb.y << 16), __uint_as_float(ogb.y & 0xffff0000u)};
            float y[4];
#pragma unroll
            for (int e = 0; e < 4; ++e) y[e] = acc[m][n][e] * rstd * nw[e] * (og[e] / (1.0f + expf(-og[e])));
            v2u w; w.x = cvt_pk_bf16(y[0], y[1]); w.y = cvt_pk_bf16(y[2], y[3]);
            *(v2u*)(P.OB + ro + 16 * n) = w; }
    }
    __syncthreads();
}

__global__ void __launch_bounds__(NWAVES * 64, 2) mk_fwd(Args args) {
    extern __shared__ __attribute__((aligned(16))) unsigned char lds_raw[];
    LAS unsigned char* lds = (LAS unsigned char*)lds_raw;
    const int G = gridDim.x, bid = blockIdx.x;
    Ctx C; C.ws = args.ws; C.out = args.out; C.sgla = args.in[3];
    const int lo = args.ph_lo, hi = args.ph_hi;
#define IN(k) (lo <= (k) && (k) < hi)
#if MK_N_LAUNCHES == 1
    volatile LAS unsigned* MISC = (volatile LAS unsigned*)(lds + MISC_OFF);
    if (threadIdx.x < 64) MISC[threadIdx.x] = 0u;
    __syncthreads();
    XcdBarrier bar = xcd_barrier_post((unsigned*)(args.ws + WS_CTL) + CW_BAR, MISC + 8);
#define SEAM(k) do { if (IN(k) && IN((k) + 1)) xcd_barrier(bar); } while (0)
#else
#define SEAM(k) do { } while (0)
#endif
#define PH_IDS const int tid = fresh_tid(), lane = tid & 63, wave = __builtin_amdgcn_readfirstlane(tid >> 6); (void)lane; (void)wave; const Ptrs P = make_ptrs(C)
#define PH_GW const int gw = bid * NWAVES + wave, NGW = G * NWAVES

    if (IN(0)) { for (int rp = 0; rp < RP_PRO; ++rp) prologue_phase(args, lds, bid, G); }
    SEAM(0);

    for (int layer = 0; layer < 4; ++layer) {
        const int jj = layer >> 1;
        const int pb = 1 + jj * 15 + (layer & 1) * 6;
        int pm;
        if ((layer & 1) == 0) {
            if (IN(pb)) { PH_IDS; for (int rp = 0; rp < RP_POOL; ++rp) pool_prep_phase(P, jj, bid, G, tid); }
            SEAM(pb);
            if (IN(pb + 1)) { PH_IDS;
                pg8::Gemm g{P.PB, P.WP + (size_t)jj * 4 * 512 * 512, D, 512, 512, 1, 512 * 2};
                pg8::StaticOrder S; S.init(MP, D, G, bid);
                pg8::EpiBf16<0> E{P.YB, D, nullptr, 0, 0};
                for (int rp = 0; rp < RP_POOL; ++rp) pg8::gemm_phase<pg8::EpiBf16<0>, pg8::StaticOrder, true>(lds, g, S, E);
                for (int rp = 0; rp < RP_MICRO; ++rp) for (int u = bid; u < 64; u += G) {
                    const int gidx = u >> 4, ct = u & 15;
                    float* slab = P.SLAB + gidx * 512 + ct * 32;
                    micro_unit<2>(P.PB + (size_t)MP * D + gidx * 512, D, P.WP + ((size_t)(jj * 4 + gidx) * 512 + ct * 32) * 512, 512, 512, lds, tid, wave, lane,
                        [=](int r, int cc, const f32x4& v) { *(f32x4*)(slab + (size_t)r * D + cc) = v; });
                }
            }
            SEAM(pb + 1);
            if (IN(pb + 2)) { PH_IDS; PH_GW; ln_phase(P, 1, nullptr, P.pool_scale + (size_t)jj * D, P.ln_mix_g + (size_t)layer * D, P.ln_mix_b + (size_t)layer * D, false, gw, NGW, lane); }
            SEAM(pb + 2);
            pm = pb + 3;
        } else {
            if (IN(pb)) { PH_IDS;
                const bf16* win = P.WIN + (size_t)jj * WIN_LAYER;
                {
                    pg8::Gemm g{P.XB, win, D, D, D, 0, 0};
                    pg8::StaticOrder S; S.init(MP, 4096, G, bid);
                    pg8::EpiBf16<0> E{P.QK, D, nullptr, 2048, (size_t)(WS_OG - WS_QK) / 2};
                    for (int rp = 0; rp < RP_GLAGEMM; ++rp) pg8::gemm_phase<pg8::EpiBf16<0>, pg8::StaticOrder, true>(lds, g, S, E);
                }
                {
                    pg8::Gemm g{win + (size_t)4096 * D, P.XB, D, D, D, 0, 0};
                    pg8::StaticOrder S; S.init(2048, MP, G, bid);
                    pg8::EpiBf16<0> E{P.VT, MP, nullptr, 0, 0};
                    for (int rp = 0; rp < RP_GLAGEMM; ++rp) pg8::gemm_phase<pg8::EpiBf16<0>, pg8::StaticOrder, true>(lds, g, S, E);
                }
                for (int rp = 0; rp < RP_MICRO; ++rp) for (int u = bid; u < 192 + 65; u += G) {
                    if (u < 192) {
                        float* o = P.SQKV + u * 32;
                        micro_unit<2>(P.XB + (size_t)MP * D, D, win + (size_t)u * 32 * D, D, D, lds, tid, wave, lane,
                            [=](int r, int cc, const f32x4& v) { *(f32x4*)(o + (size_t)r * 6144 + cc) = v; });
                    } else {
                        const int rb = u - 192;
                        float* o = P.GKL + (size_t)rb * 128 * NRANK;
                        micro_unit<1>(P.XB + (size_t)rb * 128 * D, D, win + (size_t)6144 * D, D, D, lds, tid, wave, lane,
                            [=](int r, int cc, const f32x4& v) { *(f32x4*)(o + (size_t)r * NRANK + cc) = v; });
                    }
                }
            }
            SEAM(pb);
            if (IN(pb + 1)) { PH_IDS;
                for (int rp = 0; rp < RP_GLAMIX; ++rp) for (int it = bid; it < 512; it += G) gla_prep_item(P, jj, it, lds, tid);
                for (int rp = 0; rp < RP_DEC; ++rp) for (int it = bid; it < 512; it += G) gla_decode_item(P, jj, it, lds, tid);
            }
            SEAM(pb + 1);
            if (IN(pb + 2)) { PH_IDS; for (int rp = 0; rp < RP_GLAMIX; ++rp) for (int u = bid; u < 256; u += G) gla_scan_item(P, jj, u, wave, lane); }
            SEAM(pb + 2);
            if (IN(pb + 3)) { PH_IDS; for (int rp = 0; rp < RP_GLAMIX; ++rp) for (int it = bid; it < 512; it += G) gla_out_item(P, jj, it, lds, wave, lane); }
            SEAM(pb + 3);
            if (IN(pb + 4)) { PH_IDS;
                pg8::Gemm g{P.OB, P.WOUT + (size_t)jj * D * D, D, D, D, 0, 0};
                pg8::StaticOrder S; S.init(MP, D, G, bid);
                pg8::EpiBf16<0> E{P.YB, D, nullptr, 0, 0};
                for (int rp = 0; rp < RP_GLAGEMM; ++rp) pg8::gemm_phase<pg8::EpiBf16<0>, pg8::StaticOrder, true>(lds, g, S, E);
                for (int rp = 0; rp < RP_MICRO; ++rp) for (int u = bid; u < 256; u += G) {
                    const int ct = u & 63, ks = u >> 6;
                    float* slab = P.SLAB + (size_t)ks * MS * D + ct * 32;
                    micro_unit<2>(P.OB + (size_t)MP * D + ks * 512, D, P.WOUT + (size_t)jj * D * D + (size_t)ct * 32 * D + ks * 512, D, 512, lds, tid, wave, lane,
                        [=](int r, int cc, const f32x4& v) { *(f32x4*)(slab + (size_t)r * D + cc) = v; });
                }
            }
            SEAM(pb + 4);
            if (IN(pb + 5)) { PH_IDS; PH_GW; ln_phase(P, 4, nullptr, nullptr, P.ln_mix_g + (size_t)layer * D, P.ln_mix_b + (size_t)layer * D, false, gw, NGW, lane); }
            SEAM(pb + 5);
            pm = pb + 6;
        }
        if (IN(pm)) { PH_IDS;
            const bf16* w1 = P.W1 + (size_t)layer * D * DFF; const float* b1 = P.b1 + (size_t)layer * DFF;
            pg8::Gemm g{P.XB, w1, D, D, D, 0, 0};
            pg8::StaticOrder S; S.init(MP, DFF, G, bid);
            pg8::EpiBf16<1> E{P.HB, DFF, b1, 0, 0};
            for (int rp = 0; rp < RP_MLP; ++rp) pg8::gemm_phase<pg8::EpiBf16<1>, pg8::StaticOrder, true>(lds, g, S, E);
            for (int rp = 0; rp < RP_MICRO; ++rp) for (int u = bid; u < 256; u += G) {
                bf16* o = P.HB + (size_t)MP * DFF + u * 32; const float* bb = b1 + u * 32;
                micro_unit<2>(P.XB + (size_t)MP * D, D, w1 + (size_t)u * 32 * D, D, D, lds, tid, wave, lane,
                    [=](int r, int cc, const f32x4& v) { const f32x4 bv = *(const f32x4*)(bb + cc); float y[4];
#pragma unroll
                        for (int e = 0; e < 4; ++e) { const float a = fmaxf(v[e] + bv[e], 0.f); y[e] = a * a; }
                        v2u w; w.x = cvt_pk_bf16(y[0], y[1]); w.y = cvt_pk_bf16(y[2], y[3]); *(v2u*)(o + (size_t)r * DFF + cc) = w; });
            }
        }
        SEAM(pm);
        if (IN(pm + 1)) { PH_IDS;
            const bf16* w2 = P.W2 + (size_t)layer * DFF * D;
            pg8::Gemm g{P.HB, w2, DFF, DFF, DFF, 0, 0};
            pg8::StaticOrder S; S.init(MP, D, G, bid);
            pg8::EpiBf16<0> E{P.YB, D, nullptr, 0, 0};
            for (int rp = 0; rp < RP_MLP; ++rp) pg8::gemm_phase<pg8::EpiBf16<0>, pg8::StaticOrder, true>(lds, g, S, E);
            for (int rp = 0; rp < RP_MICRO; ++rp) for (int u = bid; u < 256; u += G) {
                const int ct = u & 63, ks = u >> 6;
                float* slab = P.SLAB + (size_t)ks * MS * D + ct * 32;
                micro_unit<2>(P.HB + (size_t)MP * DFF + ks * 2048, DFF, w2 + (size_t)ct * 32 * DFF + ks * 2048, DFF, 2048, lds, tid, wave, lane,
                    [=](int r, int cc, const f32x4& v) { *(f32x4*)(slab + (size_t)r * D + cc) = v; });
            }
        }
        SEAM(pm + 1);
        if (IN(pm + 2)) { PH_IDS; PH_GW; ln_phase(P, 4, P.b2 + (size_t)layer * D, nullptr, P.ln_ffn_g + (size_t)layer * D, P.ln_ffn_b + (size_t)layer * D, layer == 3, gw, NGW, lane); }
        if (layer < 3) SEAM(pm + 2);
    }
#undef IN
#undef SEAM
}

extern "C" void kernel_launch(void* const* d_in, const int* in_sizes, int n_in, void* d_out, int out_size, void* d_ws, size_t ws_size, hipStream_t stream) {
    static int grid = 0;
    if (grid == 0) {
        if (n_in != 19 || (size_t)out_size != O_END || ws_size < WS_END) { fprintf(stderr, "kernel_launch: unexpected shapes: n_in %d out %d ws %zu\n", n_in, out_size, ws_size); grid = -1; return; }
        int dev = 0, cus = 0, per_cu = 0;
        if (hipGetDevice(&dev) != hipSuccess || hipDeviceGetAttribute(&cus, hipDeviceAttributeMultiprocessorCount, dev) != hipSuccess) { grid = -1; return; }
        if (hipFuncSetAttribute((const void*)mk_fwd, hipFuncAttributeMaxDynamicSharedMemorySize, LDS_BYTES) != hipSuccess) { fprintf(stderr, "kernel_launch: hipFuncSetAttribute failed\n"); grid = -1; return; }
        if (hipOccupancyMaxActiveBlocksPerMultiprocessor(&per_cu, (const void*)mk_fwd, NWAVES * 64, LDS_BYTES) != hipSuccess || per_cu < 1)
            fprintf(stderr, "kernel_launch: occupancy query reports %d workgroups per CU\n", per_cu);
        (void)hipGetLastError();
        grid = cus;
    }
    if (grid < 0) return;
    if (hipMemsetAsync((char*)d_ws + WS_CTL, 0, CTL_ZERO_BYTES, stream) != hipSuccess) return;
    Args a{};
    for (int i = 0; i < 19; ++i) a.in[i] = (const float*)d_in[i];
    a.out = (float*)d_out; a.ws = (unsigned char*)d_ws;
    if (MK_N_LAUNCHES == 1) {
        a.ph_lo = 0; a.ph_hi = NPHASE;
        hipLaunchKernelGGL(mk_fwd, dim3(grid), dim3(NWAVES * 64), LDS_BYTES, stream, a);
    } else {
        for (int p = 0; p < NPHASE; ++p) { a.ph_lo = p; a.ph_hi = p + 1;
            hipLaunchKernelGGL(mk_fwd, dim3(grid), dim3(NWAVES * 64), LDS_BYTES, stream, a); }
    }
}
```

```cpp
#include <hip/hip_runtime.h>
#include <cstdio>
#include <cstdint>

#ifndef MK_N_LAUNCHES
#define MK_N_LAUNCHES 1
#endif

#define RP_PRO 1
#define RP_POOL 1
#define RP_MLP 1
#define RP_GLAGEMM 1
#define RP_GLAMIX 1
#define RP_PREP 1
#define RP_SCAN 1
#define RP_GOUT 1
#define RP_MICRO 1
#define RP_DEC 1
#define GAS __attribute__((address_space(1)))
#define LAS __attribute__((address_space(3)))
typedef unsigned short bf16;
typedef unsigned v4u __attribute__((ext_vector_type(4)));
typedef unsigned v2u __attribute__((ext_vector_type(2)));
typedef float f32x4 __attribute__((ext_vector_type(4)));
typedef float f32x16 __attribute__((ext_vector_type(16)));
typedef short bf16x8 __attribute__((ext_vector_type(8)));

constexpr int D = 2048, MP = 8192, MS = 128, MT = 8320, DFF = 8192, SEQ = 2048, NBAT = 4, NH = 4, DK = 256, DV = 512, KD = 1024;
constexpr int GIN = 6160, NRANK = 16, CH = 64, NCH = 32, PCTX = 15;
constexpr float ALPHA = 1.6817928305074290f;
constexpr float LN_EPS = 1e-5f, RMS_EPS = 1e-5f;
constexpr int NPHASE = 31;
constexpr int NWAVES = 8;

constexpr size_t O_YP = 0, O_YS = 16777216, O_PP = 17039360, O_GP = 17285120, O_PS = 21479424, O_GS = 29343744, O_END = 163561472;

constexpr size_t MiB = 1u << 20;
constexpr size_t WS_CTL = 0, CTL_ZERO_BYTES = 1 * MiB;
constexpr size_t WS_WP = 1 * MiB, WS_WIN = 5 * MiB, WS_WOUT = 54 * MiB, WS_W1 = 70 * MiB, WS_W2 = 198 * MiB;
constexpr size_t WS_X32 = 326 * MiB, WS_XB = 391 * MiB, WS_Y32 = 424 * MiB, WS_PB = 488 * MiB, WS_OB = 521 * MiB, WS_HB = 554 * MiB;
constexpr size_t WS_QK = 684 * MiB, WS_OG = 716 * MiB, WS_VT = 748 * MiB, WS_QT = 780 * MiB, WS_KT = 812 * MiB, WS_ST = 828 * MiB;
constexpr size_t WS_DEC = 956 * MiB, WS_GKL = 957 * MiB, WS_SQKV = 958 * MiB, WS_SLAB = 961 * MiB, WS_PAR = 965 * MiB, WS_WSUM = 966 * MiB, WS_END = 968 * MiB;
constexpr int PAR_PSCALE = 0, PAR_WGU = 4096, PAR_GBIAS = 36864, PAR_NORMW = 38912, PAR_LNMG = 39936, PAR_LNMB = 48128, PAR_B1 = 56320, PAR_B2 = 89088, PAR_LNFG = 97280, PAR_LNFB = 105472, PAR_END = 113664;
constexpr size_t WIN_LAYER = (size_t)GIN * D;
constexpr int CW_BAR = 4096;

constexpr int LDS_BYTES = 147456;
constexpr int MISC_OFF = 147200;

__device__ __forceinline__ unsigned cvt_pk_bf16(float lo, float hi) { unsigned r; asm volatile("v_cvt_pk_bf16_f32 %0, %1, %2" : "=v"(r) : "v"(lo), "v"(hi)); return r; }
__device__ __forceinline__ unsigned pk_bf16_sw(float lo, float hi) { const unsigned a = __float_as_uint(lo), b = __float_as_uint(hi);
    return ((a + 0x7fffu + ((a >> 16) & 1u)) >> 16) | ((b + 0x7fffu + ((b >> 16) & 1u)) & 0xffff0000u); }
__device__ __forceinline__ float bf2f(unsigned short b) { return __uint_as_float(((unsigned)b) << 16); }
__device__ __forceinline__ float wave_sum(float v) {
#pragma unroll
    for (int o = 1; o < 64; o <<= 1) v += __shfl_xor(v, o);
    return v;
}
__device__ __forceinline__ float logsigmoidf(float x) { return fminf(x, 0.f) - __logf(1.0f + __expf(-fabsf(x))); }
__device__ __forceinline__ int fresh_tid() { int t = threadIdx.x; asm volatile("" : "+v"(t)); return t; }
#define LDS_WAIT() asm volatile("s_waitcnt lgkmcnt(0)" ::: "memory")
#define VM_WAIT() asm volatile("s_waitcnt vmcnt(0)" ::: "memory")

namespace pg8 {
#define PG8_LAS __attribute__((address_space(3)))
typedef unsigned short bf16_t;
typedef unsigned u32x4 __attribute__((ext_vector_type(4)));
constexpr int BM = 256, BK = 64, HALF = 128, HTB = HALF * BK * 2, STAGE_BYTES = 8 * HTB, NXCD = 8, WGM = 8;

__host__ __device__ __forceinline__ int lds_byte(int r, int c) { const int st = (r >> 4) * 2 + (c >> 5), rr = r & 15, cc = c & 31, ob = rr * 64 + cc * 2; return st * 1024 + (ob ^ (((ob >> 9) & 1) << 5)); }
__host__ __device__ __forceinline__ void stage_rc(int b, int& R, int& C) { const int st = b / 1024, sb = b % 1024, swz = sb ^ (((sb >> 9) & 1) << 5); R = (st >> 1) * 16 + swz / 64; C = (st & 1) * 32 + (swz % 64) / 2; }
__host__ __device__ __forceinline__ int perm32(int rho) { const int n = rho >> 4, i = rho & 15; return 8 * (i >> 2) + 4 * n + (i & 3); }

struct Unit { int pm, pn; };
struct Gemm { const bf16_t* A; const bf16_t* Bt; };

template <int M_, int N_> struct StaticOrder {
    static constexpr int nM = M_ / BM, nN = N_ / BM, nwg = nM * nN;
    int G, c;
    __host__ __device__ void init(int G_, int c_) { G = G_; c = c_; }
    __host__ __device__ bool next(int i, Unit& u) const {
        const long L = (long)i * G + c; if (L >= nwg) return false;
        int wgid = (int)L; { const int q = nwg / NXCD, r = nwg % NXCD, xcd = wgid % NXCD, off = wgid / NXCD; wgid = (xcd < r ? xcd * (q + 1) : r * (q + 1) + (xcd - r) * q) + off; }
        const int nig = WGM * nN, gid = wgid / nig, fm = gid * WGM, gsz = (nM - fm) < WGM ? (nM - fm) : WGM;
        u.pm = fm + ((wgid % nig) % gsz); u.pn = (wgid % nig) / gsz; return true;
    }
    __device__ __forceinline__ void a_ready(const Unit&) const {}
    __device__ __forceinline__ void done(const Unit&) const {}
};

struct EpiF32 {
    static constexpr bool PERM = false, AFTER_DRAIN = false;
    float* C; int ldc;
    __device__ __forceinline__ void operator()(const f32x4 (&acc)[2][2][4][2], const Unit& u, int wr, int wc, int fr, int fq) const {
        const int row0 = u.pm * BM + wr * 64 + fr, col0 = u.pn * BM + wc * 32 + 4 * fq;
#pragma unroll
        for (int ai = 0; ai < 2; ++ai)
#pragma unroll
            for (int m = 0; m < 4; ++m) { float* rowp = C + (size_t)(row0 + ai * HALF + m * 16) * ldc + col0;
#pragma unroll
                for (int bj = 0; bj < 2; ++bj)
#pragma unroll
                    for (int n = 0; n < 2; ++n) *(f32x4*)(rowp + bj * HALF + n * 16) = acc[ai][bj][m][n]; }
    }
};
template <int ACT  > struct EpiBf16 {
    static constexpr bool PERM = true, AFTER_DRAIN = false;
    bf16_t* O; int ldc; const float* bias; int split_cols; size_t split_stride;
    __device__ __forceinline__ void operator()(const f32x4 (&acc)[2][2][4][2], const Unit& u, int wr, int wc, int fr, int fq) const {
        const int row0 = u.pm * BM + wr * 64 + fr; int colt = u.pn * BM; bf16_t* base = O;
        if (split_cols) { const int t = colt / split_cols; base += (size_t)t * split_stride; colt -= t * split_cols; }
        const int col0 = colt + wc * 32 + 8 * fq, bcol0 = u.pn * BM + wc * 32 + 8 * fq;
        f32x4 bv[2][2];
#pragma unroll
        for (int bj = 0; bj < 2; ++bj)
#pragma unroll
            for (int n = 0; n < 2; ++n) bv[bj][n] = bias ? *(const f32x4*)(bias + bcol0 + bj * HALF + 4 * n) : (f32x4){0.f, 0.f, 0.f, 0.f};
#pragma unroll
        for (int ai = 0; ai < 2; ++ai)
#pragma unroll
            for (int m = 0; m < 4; ++m) { bf16_t* rowp = base + (size_t)(row0 + ai * HALF + m * 16) * ldc + col0;
#pragma unroll
                for (int bj = 0; bj < 2; ++bj) { f32x4 v0 = acc[ai][bj][m][0] + bv[bj][0], v1 = acc[ai][bj][m][1] + bv[bj][1];
                    if (ACT == 1) {
#pragma unroll
                        for (int j = 0; j < 4; ++j) { const float a = fmaxf(v0[j], 0.f), b = fmaxf(v1[j], 0.f); v0[j] = a * a; v1[j] = b * b; } }
                    u32x4 w; w.x = cvt_pk_bf16(v0[0], v0[1]); w.y = cvt_pk_bf16(v0[2], v0[3]); w.z = cvt_pk_bf16(v1[0], v1[1]); w.w = cvt_pk_bf16(v1[2], v1[3]);
                    *(u32x4*)(rowp + bj * HALF) = w; } }
    }
};

template <class Epi, class Sched, bool ALIGN_EPI, int LDA, int LDB, int KDIM, int A_SHIFT = 0, int A_STEP = 0>
__device__ __forceinline__ void gemm_phase(PG8_LAS unsigned char* lds, const Gemm g, const Sched& S, const Epi& E) {
    const int tid = fresh_tid(), wid = __builtin_amdgcn_readfirstlane(tid >> 6), lane = tid & 63, wr = wid >> 2, wc = wid & 3, fr = lane & 15, fq = lane >> 4;
    constexpr int nt = KDIM / BK;
    unsigned voffA[2], voffB[2];
#pragma unroll
    for (int i = 0; i < 2; ++i) { int R, C; stage_rc(tid * 16 + i * 8192, R, C); const int Rb = Epi::PERM ? ((R & ~31) + perm32(R & 31)) : R;
        voffA[i] = (unsigned)(R * LDA + C) * 2u; voffB[i] = (unsigned)(Rb * LDB + C) * 2u; }
    constexpr size_t kstep = (size_t)(BK * 2);
    constexpr size_t hstepA = (size_t)HALF * LDA * 2, hstepB = (size_t)HALF * LDB * 2;
    constexpr size_t tstepA = 2 * hstepA, tstepB = 2 * hstepB;
    const unsigned ldsw = (unsigned)wid * 1024u;
    const int aoff = lds_byte(wr * 64 + fr, fq * 8), boff = lds_byte(wc * 32 + fr, fq * 8);
#define PG8_SA(b, h) (((b) * 2 + (h)) * HTB)
#define PG8_SB(b, h) ((4 + (b) * 2 + (h)) * HTB)
#define PG8_STAGE(bufoff, gbase, voff) do { _Pragma("unroll") for (int _i = 0; _i < 2; ++_i) \
        __builtin_amdgcn_global_load_lds((const unsigned*)((const char*)(gbase) + (voff)[_i]), (PG8_LAS unsigned*)(lds + (bufoff) + ldsw + _i * 8192), 16, 0, 0); } while (0)
#define PG8_LDA(dst, b, h) do { _Pragma("unroll") for (int m = 0; m < 4; ++m) _Pragma("unroll") for (int k = 0; k < 2; ++k) dst[m][k] = *(const PG8_LAS bf16x8*)(lds + PG8_SA(b, h) + aoff + m * 2048 + k * 1024); } while (0)
#define PG8_LDB(dst, b, h) do { _Pragma("unroll") for (int n = 0; n < 2; ++n) _Pragma("unroll") for (int k = 0; k < 2; ++k) dst[n][k] = *(const PG8_LAS bf16x8*)(lds + PG8_SB(b, h) + boff + n * 2048 + k * 1024); } while (0)
#define PG8_MMA(ai, bj, At, Bt) do { __builtin_amdgcn_s_setprio(1); _Pragma("unroll") for (int m = 0; m < 4; ++m) _Pragma("unroll") for (int n = 0; n < 2; ++n) _Pragma("unroll") for (int k = 0; k < 2; ++k) \
        acc[ai][bj][m][n] = __builtin_amdgcn_mfma_f32_16x16x32_bf16(Bt[n][k], At[m][k], acc[ai][bj][m][n], 0, 0, 0); __builtin_amdgcn_s_setprio(0); } while (0)
#define PG8_WAIT_V(n) asm volatile("s_waitcnt vmcnt(" #n ")" ::: "memory")
#define PG8_WAIT_L(n) asm volatile("s_waitcnt lgkmcnt(" #n ")" ::: "memory")
#define PG8_BAR __builtin_amdgcn_s_barrier()
#define PG8_SCHED __builtin_amdgcn_sched_barrier(0)
#define PG8_APTR(u) ((const char*)g.A + (size_t)(u).pm * tstepA + (size_t)((u).pn >> A_SHIFT) * (size_t)A_STEP)
#define PG8_BPTR(u) ((const char*)g.Bt + (size_t)(u).pn * tstepB)
    Unit cur, nxt; int ui = 0;
    if (!S.next(0, cur)) return;
    f32x4 acc[2][2][4][2];
#pragma unroll
    for (int a = 0; a < 2; ++a)
#pragma unroll
        for (int b = 0; b < 2; ++b)
#pragma unroll
            for (int m = 0; m < 4; ++m)
#pragma unroll
                for (int n = 0; n < 2; ++n) acc[a][b][m][n] = (f32x4){0.f, 0.f, 0.f, 0.f};
    bf16x8 At[4][2], B0[2][2], B1[2][2];
    const char* cA = PG8_APTR(cur); const char* cB = PG8_BPTR(cur);
    S.a_ready(cur);
    PG8_STAGE(PG8_SB(0, 0), cB, voffB); PG8_STAGE(PG8_SB(0, 1), cB + hstepB, voffB); PG8_STAGE(PG8_SA(0, 0), cA, voffA); PG8_STAGE(PG8_SA(0, 1), cA + hstepA, voffA);
    if (wr == 1) PG8_BAR;
    PG8_WAIT_V(2); PG8_BAR;
    PG8_STAGE(PG8_SB(1, 0), cB + kstep, voffB); PG8_STAGE(PG8_SA(1, 0), cA + kstep, voffA); PG8_STAGE(PG8_SB(1, 1), cB + hstepB + kstep, voffB);
    PG8_WAIT_V(6); PG8_BAR;
    for (;;) {
        const bool has_next = S.next(ui + 1, nxt);
        const char* nA = has_next ? PG8_APTR(nxt) : cA; const char* nB = has_next ? PG8_BPTR(nxt) : cB;
        for (int t = 0; t < nt; t += 2) {
            const bool last = (t == nt - 2);
            const char* a1 = cA + (size_t)(t + 1) * kstep;
            const char* a2 = last ? nA : cA + (size_t)(t + 2) * kstep; const char* b2 = last ? nB : cB + (size_t)(t + 2) * kstep;
            const char* a3 = a2 + kstep; const char* b3 = b2 + kstep;
            if (last && has_next) S.a_ready(nxt);
            PG8_LDB(B0, 0, 0); PG8_LDB(B1, 0, 1); PG8_SCHED; PG8_LDA(At, 0, 0); PG8_STAGE(PG8_SA(1, 1), a1 + hstepA, voffA);
            PG8_WAIT_V(8); PG8_WAIT_L(0); PG8_BAR; PG8_MMA(0, 0, At, B0); PG8_MMA(0, 1, At, B1); PG8_BAR; PG8_SCHED;
            PG8_LDA(At, 0, 1); PG8_STAGE(PG8_SB(0, 0), b2, voffB); PG8_STAGE(PG8_SB(0, 1), b2 + hstepB, voffB); PG8_STAGE(PG8_SA(0, 0), a2, voffA);
            PG8_WAIT_V(8); PG8_WAIT_L(0); PG8_BAR; PG8_MMA(1, 0, At, B0); PG8_MMA(1, 1, At, B1); PG8_BAR; PG8_SCHED;
            PG8_LDB(B0, 1, 0); PG8_LDB(B1, 1, 1); PG8_SCHED; PG8_LDA(At, 1, 0); PG8_STAGE(PG8_SA(0, 1), a2 + hstepA, voffA);
            PG8_WAIT_V(8); PG8_WAIT_L(0); PG8_BAR; PG8_MMA(0, 0, At, B0); PG8_MMA(0, 1, At, B1); PG8_BAR; PG8_SCHED;
            PG8_LDA(At, 1, 1); PG8_STAGE(PG8_SB(1, 0), b3, voffB); PG8_STAGE(PG8_SB(1, 1), b3 + hstepB, voffB); PG8_STAGE(PG8_SA(1, 0), a3, voffA);
            PG8_WAIT_V(8); PG8_WAIT_L(0); PG8_BAR; PG8_MMA(1, 0, At, B0); PG8_MMA(1, 1, At, B1); PG8_BAR; PG8_SCHED;
        }
        if constexpr (ALIGN_EPI) { if (wr == 0) PG8_BAR; }
        E(acc, cur, wr, wc, fr, fq); S.done(cur);
        if (!has_next) break;
#pragma unroll
        for (int a = 0; a < 2; ++a)
#pragma unroll
            for (int b = 0; b < 2; ++b)
#pragma unroll
                for (int m = 0; m < 4; ++m)
#pragma unroll
                    for (int n = 0; n < 2; ++n) acc[a][b][m][n] = (f32x4){0.f, 0.f, 0.f, 0.f};
        cur = nxt; cA = nA; cB = nB; ++ui;
        if constexpr (ALIGN_EPI) { if (wr == 1) PG8_BAR; }
    }
    PG8_WAIT_V(0);
    if constexpr (!ALIGN_EPI) { if (wr == 0) PG8_BAR; }
    PG8_BAR;
#undef PG8_SA
#undef PG8_SB
#undef PG8_STAGE
#undef PG8_LDA
#undef PG8_LDB
#undef PG8_MMA
#undef PG8_WAIT_V
#undef PG8_WAIT_L
#undef PG8_BAR
#undef PG8_SCHED
#undef PG8_APTR
#undef PG8_BPTR
}
}

#define XB_TMO      128
#define XB_XCNT(j)  (256  + 64 * (j))
#define XB_XSUB(j)  (1280 + 64 * (j))
#define XB_XGEN(j)  (2304 + 64 * (j))
#define XB_TOP      3328
#define XB_TOPGEN   3392
#define XCD_BAR_WORDS 3456
#define XB_SPIN_CAP (1u << 18)

__device__ __forceinline__ unsigned xb_ld(unsigned* p)              { return __hip_atomic_load(p, __ATOMIC_RELAXED, __HIP_MEMORY_SCOPE_AGENT); }
__device__ __forceinline__ unsigned xb_add(unsigned* p, unsigned v) { return __hip_atomic_fetch_add(p, v, __ATOMIC_RELAXED, __HIP_MEMORY_SCOPE_AGENT); }
__device__ __forceinline__ unsigned xb_xcc_id() { return (unsigned)__builtin_amdgcn_s_getreg((3 << 11) | 20) & 0xFu; }
#define XB_SPIN(cond, bar) do { unsigned _sp = 0; while (cond) { __builtin_amdgcn_s_sleep(1); \
    if ((++_sp & 255u) == 0u) { if (xb_ld(&(bar)[XB_TMO])) break; if (_sp > XB_SPIN_CAP) { atomicAdd(&(bar)[XB_TMO], 1u); break; } } } } while (0)

struct XcdBarrier { unsigned* bar; unsigned x; volatile LAS unsigned* st; };

__device__ __forceinline__ XcdBarrier xcd_barrier_post(unsigned* bar, volatile LAS unsigned* st) {
    XcdBarrier b; b.bar = bar; b.x = xb_xcc_id(); b.st = st;
    if (threadIdx.x == 0) (void)xb_add(&bar[XB_XCNT(b.x)], 1u);
    return b;
}
__device__ __forceinline__ void xcd_barrier_complete(unsigned* bar, unsigned x, unsigned& nloc, unsigned& nx) {
    const unsigned G = gridDim.x * gridDim.y * gridDim.z;
    unsigned sum, cnt, mine, sp = 0u;
    for (;;) {
        sum = 0u; cnt = 0u; mine = 0u;
#pragma unroll
        for (unsigned j = 0; j < 16; ++j) { const unsigned c = xb_ld(&bar[XB_XCNT(j)]); sum += c; cnt += (c > 0u) ? 1u : 0u; mine = (j == x) ? c : mine; }
        if (sum == G) break;
        __builtin_amdgcn_s_sleep(1);
        if ((++sp & 255u) == 0u) { if (xb_ld(&bar[XB_TMO])) break; if (sp > XB_SPIN_CAP) { atomicAdd(&bar[XB_TMO], 1u); break; } }
    }
    nloc = mine > 0u ? mine : 1u; nx = cnt > 0u ? cnt : 1u;
}
__device__ __forceinline__ void xcd_barrier(const XcdBarrier& b) {
    asm volatile("s_waitcnt vmcnt(0)" ::: "memory");
    __syncthreads();
    if (threadIdx.x == 0) {
        unsigned* bar = b.bar;
        __builtin_amdgcn_s_waitcnt(0);
        unsigned nloc = b.st[0], nx = b.st[1];
        if (nloc == 0u) { xcd_barrier_complete(bar, b.x, nloc, nx); b.st[0] = nloc; b.st[1] = nx; }
        const unsigned old = xb_add(&bar[XB_XSUB(b.x)], 1u);
        const unsigned gen = old / nloc;
        if (old + 1u == (gen + 1u) * nloc) {
            __builtin_amdgcn_fence(__ATOMIC_RELEASE, "agent");
            asm volatile("s_waitcnt vmcnt(0)" ::: "memory");
            const unsigned og = xb_add(&bar[XB_TOP], 1u);
            const unsigned tg = og / nx;
            if (og + 1u == (tg + 1u) * nx) xb_add(&bar[XB_TOPGEN], 1u);
            else XB_SPIN(xb_ld(&bar[XB_TOPGEN]) == tg, bar);
            __builtin_amdgcn_fence(__ATOMIC_ACQUIRE, "agent");
            xb_add(&bar[XB_XGEN(b.x)], 1u);
            asm volatile("s_waitcnt vmcnt(0)" ::: "memory");
        } else {
            XB_SPIN(xb_ld(&bar[XB_XGEN(b.x)]) == gen, bar);
            __builtin_amdgcn_fence(__ATOMIC_ACQUIRE, "agent");
            asm volatile("s_waitcnt vmcnt(0)" ::: "memory");
        }
    }
    __syncthreads();
}

__device__ __forceinline__ void tr_item(const float* W, int ldw, int k0, int n0, bf16* WT, int ldk, int drow0, LAS float* scr, int lane) {
    const int lc = lane & 15, lr = lane >> 4;
#pragma unroll 4
    for (int i = 0; i < 16; ++i) {
        const int kk = 4 * i + lr;
        const f32x4 v = *(const f32x4*)(W + (size_t)(k0 + kk) * ldw + n0 + 4 * lc);
        LAS float* s = scr + kk * 65 + 4 * lc;
        s[0] = v[0]; s[1] = v[1]; s[2] = v[2]; s[3] = v[3];
    }
    LDS_WAIT(); asm volatile("" ::: "memory");
    const int c = lane & 7;
#pragma unroll
    for (int j = 0; j < 8; ++j) { const int n = (lane >> 3) + 8 * j; const LAS float* s = scr + (8 * c) * 65 + n;
        v4u o; o.x = cvt_pk_bf16(s[0 * 65], s[1 * 65]); o.y = cvt_pk_bf16(s[2 * 65], s[3 * 65]); o.z = cvt_pk_bf16(s[4 * 65], s[5 * 65]); o.w = cvt_pk_bf16(s[6 * 65], s[7 * 65]);
        *(v4u*)(WT + (size_t)(drow0 + n) * ldk + k0 + 8 * c) = o; }
    LDS_WAIT(); asm volatile("" ::: "memory");
}

struct Ctx { unsigned char* ws; float* out; const float* sgla; };
struct Ptrs {
    const float *state_gla, *pool_scale, *w_gu, *gate_bias, *norm_w, *ln_mix_g, *ln_mix_b, *b1, *b2, *ln_ffn_g, *ln_ffn_b, *WSUM;
    float* out;
    bf16 *WP, *WIN, *WOUT, *W1, *W2, *XB, *PB, *OB, *HB, *QK, *OG, *VT, *QT, *KT, *ST;
    bf16* YB;
    float *DEC, *GKL, *SQKV, *SLAB;
};
__device__ __forceinline__ Ptrs make_ptrs(const Ctx& C) {
    Ptrs P; unsigned char* ws = C.ws; float* outp = C.out; const float* sgla = C.sgla;
    asm volatile("" : "+s"(ws), "+s"(outp), "+s"(sgla));
    float* par = (float*)(ws + WS_PAR);
    P.state_gla = sgla; P.out = outp;
    P.pool_scale = par + PAR_PSCALE; P.w_gu = par + PAR_WGU; P.gate_bias = par + PAR_GBIAS; P.norm_w = par + PAR_NORMW; P.ln_mix_g = par + PAR_LNMG; P.ln_mix_b = par + PAR_LNMB;
    P.b1 = par + PAR_B1; P.b2 = par + PAR_B2; P.ln_ffn_g = par + PAR_LNFG; P.ln_ffn_b = par + PAR_LNFB; P.WSUM = (const float*)(ws + WS_WSUM);
    P.WP = (bf16*)(ws + WS_WP); P.WIN = (bf16*)(ws + WS_WIN); P.WOUT = (bf16*)(ws + WS_WOUT); P.W1 = (bf16*)(ws + WS_W1); P.W2 = (bf16*)(ws + WS_W2);
    P.XB = (bf16*)(ws + WS_XB); P.PB = (bf16*)(ws + WS_PB); P.OB = (bf16*)(ws + WS_OB); P.HB = (bf16*)(ws + WS_HB);
    P.QK = (bf16*)(ws + WS_QK); P.OG = (bf16*)(ws + WS_OG); P.VT = (bf16*)(ws + WS_VT); P.QT = (bf16*)(ws + WS_QT); P.KT = (bf16*)(ws + WS_KT); P.ST = (bf16*)(ws + WS_ST);
    P.YB = (bf16*)(ws + WS_Y32); P.DEC = (float*)(ws + WS_DEC); P.GKL = (float*)(ws + WS_GKL); P.SQKV = (float*)(ws + WS_SQKV); P.SLAB = (float*)(ws + WS_SLAB);
    return P;
}

struct Args { const float* in[19]; float* out; unsigned char* ws; int ph_lo, ph_hi; };
__device__ __forceinline__ void copy_par(const float* src, float* dst, int n, int gtid, int NGT) { for (int e = gtid; e < n; e += NGT) dst[e] = src[e]; }
__device__ __forceinline__ void prologue_phase(const Args& A, LAS unsigned char* lds, int bid, int G) {
    const int tid = fresh_tid(), lane = tid & 63, wave = __builtin_amdgcn_readfirstlane(tid >> 6);
    const int gw = bid * NWAVES + wave, NGW = G * NWAVES, gtid = bid * (NWAVES * 64) + tid, NGT = G * NWAVES * 64;
    unsigned char* ws = A.ws;
    const float *xp = A.in[0], *xs = A.in[1], *state_pool = A.in[2], *pool_w = A.in[4], *w_in = A.in[6], *w_out = A.in[10], *w1 = A.in[13], *w2 = A.in[15];
    bf16 *WP = (bf16*)(ws + WS_WP), *WIN = (bf16*)(ws + WS_WIN), *WOUT = (bf16*)(ws + WS_WOUT), *W1 = (bf16*)(ws + WS_W1), *W2 = (bf16*)(ws + WS_W2);
    LAS float* scr = (LAS float*)(lds + wave * 16640);
    constexpr int T_POOL = 8 * 64, T_IN = 2 * 32 * 96, T_OUT = 2 * 32 * 32, T_1 = 4 * 32 * 128, T_2 = 4 * 128 * 32;
    constexpr int NT = T_POOL + T_IN + T_OUT + T_1 + T_2;
    for (int it = gw; it < NT; it += NGW) {
        int r = it;
        if (r < T_POOL) { const int mtx = r >> 6, t = r & 63, kb = t >> 3, nb = t & 7;
            tr_item(pool_w + (size_t)mtx * 512 * 512, 512, kb * 64, nb * 64, WP + (size_t)mtx * 512 * 512, 512, nb * 64, scr, lane); continue; }
        r -= T_POOL;
        if (r < T_IN) { const int l = r / (32 * 96), t = r % (32 * 96), kb = t / 96, nb = t % 96; const int n0 = nb * 64;
            const int drow = n0 < 2048 ? n0 : (n0 < 4096 ? n0 + 2048 : n0 - 2048);
            tr_item(w_in + (size_t)l * D * GIN, GIN, kb * 64, n0, WIN + (size_t)l * WIN_LAYER, D, drow, scr, lane); continue; }
        r -= T_IN;
        if (r < T_OUT) { const int l = r >> 10, t = r & 1023, kb = t >> 5, nb = t & 31;
            tr_item(w_out + (size_t)l * D * D, D, kb * 64, nb * 64, WOUT + (size_t)l * D * D, D, nb * 64, scr, lane); continue; }
        r -= T_OUT;
        if (r < T_1) { const int l = r >> 12, t = r & 4095, kb = t >> 7, nb = t & 127;
            tr_item(w1 + (size_t)l * D * DFF, DFF, kb * 64, nb * 64, W1 + (size_t)l * D * DFF, D, nb * 64, scr, lane); continue; }
        r -= T_1;
        { const int l = r >> 12, t = r & 4095, kb = t >> 5, nb = t & 31;
            tr_item(w2 + (size_t)l * DFF * D, D, kb * 64, nb * 64, W2 + (size_t)l * DFF * D, DFF, nb * 64, scr, lane); }
    }
    for (int e = gtid; e < 2 * NRANK * D; e += NGT) { const int l = e / (NRANK * D), rem = e % (NRANK * D), n = rem / D, k = rem % D;
        const float v = w_in[(size_t)l * D * GIN + (size_t)k * GIN + 6144 + n];
        WIN[(size_t)l * WIN_LAYER + (size_t)(6144 + n) * D + k] = (bf16)(cvt_pk_bf16(v, 0.f) & 0xffffu); }
    bf16* XB = (bf16*)(ws + WS_XB);
    for (int e = gtid; e < MT * D / 4; e += NGT) {
        const size_t o = (size_t)e * 4; const int r = (int)(o / D), c = (int)(o % D);
        const f32x4 v = r < MP ? *(const f32x4*)(xp + o) : *(const f32x4*)(xs + (o - (size_t)MP * D));
        v2u w; w.x = cvt_pk_bf16(v[0], v[1]); w.y = cvt_pk_bf16(v[2], v[3]); *(v2u*)(XB + o) = w;
        if (r < MP) { const int b = r / SEQ, l = r % SEQ; if (l >= SEQ - PCTX) *(f32x4*)(A.out + O_PP + ((size_t)b * PCTX + (l - (SEQ - PCTX))) * D + c) = v; }
        else *(f32x4*)(A.out + O_PS + ((size_t)(r - MP) * PCTX + (PCTX - 1)) * D + c) = v;
    }
    float* par = (float*)(ws + WS_PAR);
    copy_par(A.in[5], par + PAR_PSCALE, 2 * D, gtid, NGT);           copy_par(A.in[7], par + PAR_WGU, 2 * NRANK * KD, gtid, NGT);
    copy_par(A.in[8], par + PAR_GBIAS, 2 * KD, gtid, NGT);           copy_par(A.in[9], par + PAR_NORMW, 2 * DV, gtid, NGT);
    copy_par(A.in[11], par + PAR_LNMG, 4 * D, gtid, NGT);            copy_par(A.in[12], par + PAR_LNMB, 4 * D, gtid, NGT);
    copy_par(A.in[14], par + PAR_B1, 4 * DFF, gtid, NGT);            copy_par(A.in[16], par + PAR_B2, 4 * D, gtid, NGT);
    copy_par(A.in[17], par + PAR_LNFG, 4 * D, gtid, NGT);            copy_par(A.in[18], par + PAR_LNFB, 4 * D, gtid, NGT);
    float* WSUM = (float*)(ws + WS_WSUM);
    for (int e = gtid; e < 2 * MS * (D / 4); e += NGT) {
        const int c = (e % (D / 4)) * 4, js = e / (D / 4);
        const int w = 2 << (c >> 9);
        const float* ctx = state_pool + (size_t)js * PCTX * D + c;
        float* octx = A.out + O_PS + (size_t)js * PCTX * D + c;
        f32x4 s = (f32x4){0.f, 0.f, 0.f, 0.f};
        for (int i = 0; i < PCTX; ++i) { const f32x4 cv = *(const f32x4*)(ctx + (size_t)i * D);
            if (i >= PCTX - (w - 1)) s += cv;
            if (i >= 1) *(f32x4*)(octx + (size_t)(i - 1) * D) = cv; }
        *(f32x4*)(WSUM + (size_t)js * D + c) = s;
    }
}

__device__ __forceinline__ void unpack8(const v4u w, float (&f)[8]) {
    f[0] = __uint_as_float(w.x << 16); f[1] = __uint_as_float(w.x & 0xffff0000u); f[2] = __uint_as_float(w.y << 16); f[3] = __uint_as_float(w.y & 0xffff0000u);
    f[4] = __uint_as_float(w.z << 16); f[5] = __uint_as_float(w.z & 0xffff0000u); f[6] = __uint_as_float(w.w << 16); f[7] = __uint_as_float(w.w & 0xffff0000u);
}
__device__ __forceinline__ void ln_phase(const Ptrs& P, int nsplit, const float* bias, const float* scale, const float* gam, const float* bet, bool last, int gw, int NGW, int lane) {
    for (int r = gw; r < MT; r += NGW) {
        float v[4][8];
        const bf16* xr = P.XB + (size_t)r * D;
        if (r < MP) { const bf16* yr = P.YB + (size_t)r * D;
#pragma unroll
            for (int j = 0; j < 4; ++j) unpack8(*(const v4u*)(yr + 8 * lane + 512 * j), v[j]);
        } else {
#pragma unroll
            for (int j = 0; j < 4; ++j)
#pragma unroll
                for (int e = 0; e < 8; ++e) v[j][e] = 0.f;
            for (int s = 0; s < nsplit; ++s) { const float* yr = P.SLAB + ((size_t)s * MS + (r - MP)) * D;
#pragma unroll
                for (int j = 0; j < 4; ++j) { const f32x4 a = *(const f32x4*)(yr + 8 * lane + 512 * j), b = *(const f32x4*)(yr + 8 * lane + 512 * j + 4);
#pragma unroll
                    for (int e = 0; e < 4; ++e) { v[j][e] += a[e]; v[j][4 + e] += b[e]; } } }
        }
        float sum = 0.f;
#pragma unroll
        for (int j = 0; j < 4; ++j) { const int c = 8 * lane + 512 * j;
            float xv[8]; unpack8(*(const v4u*)(xr + c), xv);
            if (bias) { const f32x4 a = *(const f32x4*)(bias + c), b = *(const f32x4*)(bias + c + 4);
#pragma unroll
                for (int e = 0; e < 4; ++e) { v[j][e] += a[e]; v[j][4 + e] += b[e]; } }
            if (scale) { const f32x4 a = *(const f32x4*)(scale + c), b = *(const f32x4*)(scale + c + 4);
#pragma unroll
                for (int e = 0; e < 4; ++e) { v[j][e] *= a[e]; v[j][4 + e] *= b[e]; } }
#pragma unroll
            for (int e = 0; e < 8; ++e) { v[j][e] += ALPHA * xv[e]; sum += v[j][e]; } }
        const float mean = wave_sum(sum) * (1.f / D); float s2 = 0.f;
#pragma unroll
        for (int j = 0; j < 4; ++j)
#pragma unroll
            for (int e = 0; e < 8; ++e) { v[j][e] -= mean; s2 += v[j][e] * v[j][e]; }
        const float rstd = 1.0f / sqrtf(wave_sum(s2) * (1.f / D) + LN_EPS);
        float* o32 = r < MP ? P.out + O_YP + (size_t)r * D : P.out + O_YS + (size_t)(r - MP) * D;
        bf16* ob = P.XB + (size_t)r * D;
#pragma unroll
        for (int j = 0; j < 4; ++j) { const int c = 8 * lane + 512 * j;
            const f32x4 ga = *(const f32x4*)(gam + c), gb = *(const f32x4*)(gam + c + 4), ba = *(const f32x4*)(bet + c), bb = *(const f32x4*)(bet + c + 4);
            float y[8];
#pragma unroll
            for (int e = 0; e < 4; ++e) { y[e] = v[j][e] * rstd * ga[e] + ba[e]; y[4 + e] = v[j][4 + e] * rstd * gb[e] + bb[e]; }
            if (last) { *(f32x4*)(o32 + c) = (f32x4){y[0], y[1], y[2], y[3]}; *(f32x4*)(o32 + c + 4) = (f32x4){y[4], y[5], y[6], y[7]}; }
            else { v4u w; w.x = cvt_pk_bf16(y[0], y[1]); w.y = cvt_pk_bf16(y[2], y[3]); w.z = cvt_pk_bf16(y[4], y[5]); w.w = cvt_pk_bf16(y[6], y[7]); *(v4u*)(ob + c) = w; } }
    }
}

__device__ __forceinline__ f32x4 ld4bf(const bf16* p) { const v2u w = *(const v2u*)p; return (f32x4){__uint_as_float(w.x << 16), __uint_as_float(w.x & 0xffff0000u), __uint_as_float(w.y << 16), __uint_as_float(w.y & 0xffff0000u)}; }
__device__ __forceinline__ void pool_prep_phase(const Ptrs& P, int j, int bid, int G, int tid) {
    const int c = tid * 4, g = tid >> 7, w = 2 << g;
    const bf16* X = P.XB;
    for (int blk = bid; blk < MP / 32; blk += G) {
        const int r0 = blk * 32, b = r0 / SEQ, l0 = r0 % SEQ;
        f32x4 s = (f32x4){0.f, 0.f, 0.f, 0.f};
        for (int i = 1; i < w; ++i) { const int l = l0 - i; if (l >= 0) s += ld4bf(X + (size_t)(b * SEQ + l) * D + c); }
        for (int t = 0; t < 32; ++t) {
            const int l = l0 + t; const size_t ro = (size_t)(r0 + t) * D + c;
            const f32x4 xv = ld4bf(X + ro);
            s += xv;
            const float inv = 1.0f / (float)(l + 1 < w ? l + 1 : w);
            const f32x4 p = s * inv - xv;
            v2u o; o.x = cvt_pk_bf16(p[0], p[1]); o.y = cvt_pk_bf16(p[2], p[3]); *(v2u*)(P.PB + ro) = o;
            const int lo = l - w + 1; if (lo >= 0) s -= ld4bf(X + (size_t)(b * SEQ + lo) * D + c);
            if (j > 0 && l >= SEQ - PCTX) *(f32x4*)(P.out + O_PP + ((size_t)(j * NBAT + b) * PCTX + (l - (SEQ - PCTX))) * D + c) = xv;
        }
    }
    for (int sidx = bid; sidx < MS; sidx += G) {
        const size_t ro = (size_t)(MP + sidx) * D + c;
        const f32x4 xv = ld4bf(X + ro);
        const f32x4 s = xv + *(const f32x4*)(P.WSUM + (size_t)(j * MS + sidx) * D + c);
        if (j > 0) *(f32x4*)(P.out + O_PS + ((size_t)(j * MS + sidx) * PCTX + (PCTX - 1)) * D + c) = xv;
        const f32x4 p = s * (1.0f / (float)w) - xv;
        v2u o; o.x = cvt_pk_bf16(p[0], p[1]); o.y = cvt_pk_bf16(p[2], p[3]); *(v2u*)(P.PB + ro) = o;
    }
}

template <int NT, int LDA, int LDB, int KC, class F>
__device__ __forceinline__ void micro_unit(const bf16* A, const bf16* Bt, LAS unsigned char* lds, int tid, int wid, int lane, const F& store) {
    constexpr int PITCH = 16 * NT + 4, WSZ = 128 * PITCH, kw = KC >> 3;
    const int fr = lane & 15, fq = lane >> 4;
    const unsigned voffA = (unsigned)(fr * LDA + fq * 8) * 2u, voffB = (unsigned)(fr * LDB + fq * 8) * 2u;
    const char* abase = (const char*)(A + wid * kw);
    const char* bbase = (const char*)(Bt + wid * kw);
    f32x4 acc[8][NT];
#pragma unroll
    for (int m = 0; m < 8; ++m)
#pragma unroll
        for (int n = 0; n < NT; ++n) acc[m][n] = (f32x4){0.f, 0.f, 0.f, 0.f};
    for (int k = 0; k < kw; k += 64) {
        bf16x8 a[2][8], b[2][NT];
#pragma unroll
        for (int kk = 0; kk < 2; ++kk) {
#pragma unroll
            for (int m = 0; m < 8; ++m) a[kk][m] = *(const bf16x8*)(abase + (size_t)((16 * m) * LDA + k + kk * 32) * 2 + voffA);
#pragma unroll
            for (int n = 0; n < NT; ++n) b[kk][n] = *(const bf16x8*)(bbase + (size_t)((16 * n) * LDB + k + kk * 32) * 2 + voffB); }
#pragma unroll
        for (int kk = 0; kk < 2; ++kk)
#pragma unroll
            for (int m = 0; m < 8; ++m)
#pragma unroll
                for (int n = 0; n < NT; ++n) acc[m][n] = __builtin_amdgcn_mfma_f32_16x16x32_bf16(b[kk][n], a[kk][m], acc[m][n], 0, 0, 0);
    }
    LAS float* part = (LAS float*)lds + (wid & 3) * WSZ + fr * PITCH + 4 * fq;
    if (wid >= 4) {
#pragma unroll
        for (int m = 0; m < 8; ++m)
#pragma unroll
            for (int n = 0; n < NT; ++n) *(LAS f32x4*)(part + 16 * m * PITCH + 16 * n) = acc[m][n];
    }
    LDS_WAIT(); __syncthreads();
    if (wid < 4) {
#pragma unroll
        for (int m = 0; m < 8; ++m)
#pragma unroll
            for (int n = 0; n < NT; ++n) { acc[m][n] += *(LAS f32x4*)(part + 16 * m * PITCH + 16 * n); }
    }
    LDS_WAIT(); __syncthreads();
    if (wid < 4) {
#pragma unroll
        for (int m = 0; m < 8; ++m)
#pragma unroll
            for (int n = 0; n < NT; ++n) *(LAS f32x4*)(part + 16 * m * PITCH + 16 * n) = acc[m][n];
    }
    LDS_WAIT(); __syncthreads();
#pragma unroll
    for (int i = 0; i < NT; ++i) { const int idx = tid + 512 * i, row = idx / (4 * NT), c4 = (idx % (4 * NT)) * 4;
        const LAS float* q = (const LAS float*)lds + row * PITCH + c4;
        const f32x4 sum = (*(const LAS f32x4*)q + *(const LAS f32x4*)(q + WSZ)) + (*(const LAS f32x4*)(q + 2 * WSZ) + *(const LAS f32x4*)(q + 3 * WSZ));
        store(row, c4, sum); }
    __syncthreads();
}

__device__ __forceinline__ void gla_prep_item(const Ptrs& P, int j, int item, LAS unsigned char* lds, int tid) {
    const int h = item & 3, c = (item >> 2) & 31, b = item >> 7;
    const int k = tid & 255, half = tid >> 8, col = h * DK + k;
    const int t0 = b * SEQ + c * CH + half * 32;
    LAS float* tot = (LAS float*)lds;
    float wg[NRANK];
#pragma unroll
    for (int r = 0; r < NRANK; ++r) wg[r] = P.w_gu[(size_t)j * NRANK * KD + (size_t)r * KD + col];
    const float gb = P.gate_bias[(size_t)j * KD + col];
    float bc[32]; float run = 0.f;
#pragma unroll
    for (int t = 0; t < 32; ++t) {
        const float* gl = P.GKL + (size_t)(t0 + t) * NRANK;
        float gsum = gb;
#pragma unroll
        for (int r = 0; r < NRANK; ++r) gsum += gl[r] * wg[r];
        run += logsigmoidf(gsum) * (1.0f / 16.0f);
        bc[t] = run;
    }
    tot[half * 256 + k] = run;
    LDS_WAIT(); __syncthreads();
    const float t_lo = tot[k], t_hi = tot[256 + k];
    const float blast = t_lo + t_hi, add = half ? t_lo : 0.f;
    unsigned kh[16];
    const float qscale = 0.0625f;
#pragma unroll
    for (int t = 0; t < 32; t += 2) {
        float khat[2];
#pragma unroll
        for (int u = 0; u < 2; ++u) {
            const size_t ro = (size_t)(t0 + t + u) * D;
            const float bcv = bc[t + u] + add;
            const float qv = bf2f(P.QK[ro + col]), kv = bf2f(P.QK[ro + KD + col]);
            const float e = __expf(bcv);
            P.QT[ro + col] = (bf16)(cvt_pk_bf16(qv * qscale * e, 0.f) & 0xffffu);
            P.QT[ro + KD + col] = (bf16)(cvt_pk_bf16(kv * __expf(-bcv), 0.f) & 0xffffu);
            khat[u] = kv * __expf(blast - bcv);
        }
        kh[t >> 1] = cvt_pk_bf16(khat[0], khat[1]);
    }
    bf16* kt = P.KT + (size_t)col * MP + t0;
#pragma unroll
    for (int q = 0; q < 4; ++q) { v4u o; o.x = kh[4 * q]; o.y = kh[4 * q + 1]; o.z = kh[4 * q + 2]; o.w = kh[4 * q + 3]; *(v4u*)(kt + 8 * q) = o; }
    if (half == 0) P.DEC[(size_t)(b * NCH + c) * KD + col] = __expf(blast);
    __syncthreads();
}

__device__ __forceinline__ void gla_decode_item(const Ptrs& P, int j, int item, LAS unsigned char* lds, int tid) {
    const int h = item & 3, s = item >> 2;
    LAS float* sa = (LAS float*)lds;
    LAS float* sk = sa + 256;
    LAS float* sq = sk + 256;
    LAS float* so = sq + 256;
    LAS float* sr = so + 2048;
    const float* qkv = P.SQKV + (size_t)s * 6144;
    if (tid < 256) {
        const int col = h * DK + tid;
        const float* gl = P.GKL + (size_t)(MP + s) * NRANK;
        float gsum = P.gate_bias[(size_t)j * KD + col];
#pragma unroll
        for (int r = 0; r < NRANK; ++r) gsum += gl[r] * P.w_gu[(size_t)j * NRANK * KD + (size_t)r * KD + col];
        sa[tid] = expf(logsigmoidf(gsum) * (1.0f / 16.0f));
        sk[tid] = qkv[KD + col];
        sq[tid] = qkv[col] * 0.0625f;
    }
    LDS_WAIT(); __syncthreads();
    const int v4 = tid & 127, kq = tid >> 7;
    const f32x4 vv = *(const f32x4*)(qkv + 4096 + h * DV + 4 * v4);
    const size_t sbase = ((size_t)((j * MS + s) * NH + h)) * DK * DV + 4 * v4;
    const float* Sin = P.state_gla + sbase; float* Sout = P.out + O_GS + sbase;
    f32x4 o = (f32x4){0.f, 0.f, 0.f, 0.f};
#pragma unroll 8
    for (int i = 0; i < 64; ++i) { const int kk = kq + 4 * i;
        const f32x4 S = __builtin_nontemporal_load((const f32x4*)(Sin + (size_t)kk * DV));
        const f32x4 Sn = S * sa[kk] + vv * sk[kk];
        __builtin_nontemporal_store(Sn, (f32x4*)(Sout + (size_t)kk * DV));
        o += Sn * sq[kk]; }
    *(LAS f32x4*)(so + kq * 512 + 4 * v4) = o;
    LDS_WAIT(); __syncthreads();
    f32x4 ot = (f32x4){0.f, 0.f, 0.f, 0.f};
    if (tid < 128) {
        ot = *(LAS f32x4*)(so + 4 * tid) + *(LAS f32x4*)(so + 512 + 4 * tid) + *(LAS f32x4*)(so + 1024 + 4 * tid) + *(LAS f32x4*)(so + 1536 + 4 * tid);
        const float ss = wave_sum((ot[0] * ot[0] + ot[1] * ot[1]) + (ot[2] * ot[2] + ot[3] * ot[3]));
        if ((tid & 63) == 0) sr[tid >> 6] = ss;
    }
    LDS_WAIT(); __syncthreads();
    if (tid < 128) {
        const float rstd = 1.0f / sqrtf((sr[0] + sr[1]) * (1.0f / DV) + RMS_EPS);
        const f32x4 nw = *(const f32x4*)(P.norm_w + (size_t)j * DV + 4 * tid);
        const f32x4 og = *(const f32x4*)(qkv + 2048 + h * DV + 4 * tid);
        f32x4 y;
#pragma unroll
        for (int e = 0; e < 4; ++e) y[e] = ot[e] * rstd * nw[e] * (og[e] / (1.0f + expf(-og[e])));
        v2u w; w.x = cvt_pk_bf16(y[0], y[1]); w.y = cvt_pk_bf16(y[2], y[3]);
        *(v2u*)(P.OB + (size_t)(MP + s) * D + h * DV + 4 * tid) = w;
    }
    __syncthreads();
}

__device__ __forceinline__ void gla_scan_item(const Ptrs& P, int j, int u, int wid, int lane) {
    const int bh = u >> 4, tile = u & 15, tdk = tile >> 2, tdv = tile & 3, b = bh >> 2, h = bh & 3;
    const int wdv = wid & 3, wdk = wid >> 2, dv0 = tdv * 128 + wdv * 32, dk0 = tdk * 64 + wdk * 32;
    const int r32 = lane & 31, hi = lane >> 5;
    const bf16* krow = P.KT + (size_t)(h * DK + dk0 + r32) * MP + b * SEQ + 8 * hi;
    const bf16* vrow = P.VT + (size_t)(h * DV + dv0 + r32) * MP + b * SEQ + 8 * hi;
    const float* dec = P.DEC + (size_t)(b * NCH) * KD + h * DK + dk0 + 4 * hi;
    const int dv = dv0 + r32;
    bf16* stw = P.ST + (size_t)(bh * NCH) * DV * DK + ((size_t)(((dv >> 4) * 8 + (dk0 >> 5)) * 4) * 16 + (dv & 15)) * 8 + 4 * hi;
    f32x16 acc;
#pragma unroll
    for (int r = 0; r < 16; ++r) acc[r] = 0.f;
    for (int c0 = 0; c0 < NCH; c0 += 4) {
        bf16x8 a[4][4], bb[4][4]; f32x4 d[4][4];
#pragma unroll
        for (int cc = 0; cc < 4; ++cc) {
#pragma unroll
            for (int kk = 0; kk < 4; ++kk) { a[cc][kk] = *(const bf16x8*)(krow + (c0 + cc) * CH + kk * 16); bb[cc][kk] = *(const bf16x8*)(vrow + (c0 + cc) * CH + kk * 16); }
#pragma unroll
            for (int rg = 0; rg < 4; ++rg) d[cc][rg] = *(const f32x4*)(dec + (size_t)(c0 + cc) * KD + 8 * rg); }
#pragma unroll
        for (int cc = 0; cc < 4; ++cc) {
            bf16* stc = stw + (size_t)(c0 + cc) * DV * DK;
#pragma unroll
            for (int rg = 0; rg < 4; ++rg) { v2u w; w.x = pk_bf16_sw(acc[4 * rg], acc[4 * rg + 1]); w.y = pk_bf16_sw(acc[4 * rg + 2], acc[4 * rg + 3]);
                *(v2u*)(stc + rg * 128) = w; }
#pragma unroll
            for (int rg = 0; rg < 4; ++rg)
#pragma unroll
                for (int i = 0; i < 4; ++i) acc[4 * rg + i] *= d[cc][rg][i];
#pragma unroll
            for (int kk = 0; kk < 4; ++kk) acc = __builtin_amdgcn_mfma_f32_32x32x16_bf16(a[cc][kk], bb[cc][kk], acc, 0, 0, 0);
        }
    }
    float* og = P.out + O_GP + ((size_t)((j * NBAT + b) * NH + h)) * DK * DV + (size_t)(dk0 + 4 * hi) * DV + dv;
#pragma unroll
    for (int rg = 0; rg < 4; ++rg)
#pragma unroll
        for (int i = 0; i < 4; ++i) og[(size_t)(8 * rg + i) * DV] = acc[4 * rg + i];
}

__device__ __forceinline__ void gla_out_item(const Ptrs& P, int j, int item, LAS unsigned char* lds, int tid, int wid, int lane) {
    const int c = item & 31, bh = item >> 5, b = bh >> 2, h = bh & 3;
    const int t0 = b * SEQ + c * CH;
    const int fr = lane & 15, fq = lane >> 4;
    constexpr int QP = 264;
    LAS bf16* qs = (LAS bf16*)lds;
    LAS bf16* ks = qs + 64 * QP;
    LAS bf16* attn = ks + 64 * QP;
    LAS float* ssq = (LAS float*)(attn + 64 * 72);
    {
        const int row = tid >> 3, pc = tid & 7;
        const bf16* src = P.QT + (size_t)(t0 + row) * D + h * DK + pc * 32;
        v4u q0 = *(const v4u*)(src), q1 = *(const v4u*)(src + 8), q2 = *(const v4u*)(src + 16), q3 = *(const v4u*)(src + 24);
        v4u k0 = *(const v4u*)(src + KD), k1 = *(const v4u*)(src + KD + 8), k2 = *(const v4u*)(src + KD + 16), k3 = *(const v4u*)(src + KD + 24);
        LAS v4u* qd = (LAS v4u*)(qs + row * QP + pc * 32); LAS v4u* kd = (LAS v4u*)(ks + row * QP + pc * 32);
        qd[0] = q0; qd[1] = q1; qd[2] = q2; qd[3] = q3; kd[0] = k0; kd[1] = k1; kd[2] = k2; kd[3] = k3;
    }
    v2u ogb[4][4];
#pragma unroll
    for (int m = 0; m < 4; ++m)
#pragma unroll
        for (int n = 0; n < 4; ++n) ogb[m][n] = *(const v2u*)(P.OG + (size_t)(t0 + 16 * m + fr) * D + h * DV + 64 * wid + 16 * n + 4 * fq);
    LDS_WAIT(); __syncthreads();
    {
        const int it = wid & 3, jh = wid >> 2;
        f32x4 a2[2] = {(f32x4){0.f, 0.f, 0.f, 0.f}, (f32x4){0.f, 0.f, 0.f, 0.f}};
        const LAS bf16* qrow = qs + (16 * it + fr) * QP + 8 * fq;
        const LAS bf16* krow0 = ks + (32 * jh + fr) * QP + 8 * fq;
        const LAS bf16* krow1 = krow0 + 16 * QP;
#pragma unroll
        for (int k = 0; k < DK; k += 32) {
            const bf16x8 qa = *(const LAS bf16x8*)(qrow + k), k0v = *(const LAS bf16x8*)(krow0 + k), k1v = *(const LAS bf16x8*)(krow1 + k);
            a2[0] = __builtin_amdgcn_mfma_f32_16x16x32_bf16(k0v, qa, a2[0], 0, 0, 0);
            a2[1] = __builtin_amdgcn_mfma_f32_16x16x32_bf16(k1v, qa, a2[1], 0, 0, 0);
        }
        const int i = 16 * it + fr;
#pragma unroll
        for (int jj = 0; jj < 2; ++jj) { const int j0 = 32 * jh + 16 * jj + 4 * fq;
            float v[4];
#pragma unroll
            for (int e = 0; e < 4; ++e) v[e] = (j0 + e <= i) ? a2[jj][e] : 0.f;
            v2u w; w.x = cvt_pk_bf16(v[0], v[1]); w.y = cvt_pk_bf16(v[2], v[3]);
            *(LAS v2u*)(attn + i * 72 + j0) = w; }
    }
    f32x4 acc[4][4];
#pragma unroll
    for (int m = 0; m < 4; ++m)
#pragma unroll
        for (int n = 0; n < 4; ++n) acc[m][n] = (f32x4){0.f, 0.f, 0.f, 0.f};
    {
        const bf16* sfr = P.ST + (size_t)(bh * NCH + c) * DV * DK + ((size_t)(4 * wid) * 8 * 64 + lane) * 8;
        const LAS bf16* qrow = qs + fr * QP + 8 * fq;
#pragma unroll
        for (int k4 = 0; k4 < 8; k4 += 4) {
            bf16x8 sb[4][4];
#pragma unroll
            for (int kq = 0; kq < 4; ++kq)
#pragma unroll
                for (int n = 0; n < 4; ++n) sb[kq][n] = *(const bf16x8*)(sfr + ((size_t)(n * 8 + k4 + kq) * 64) * 8);
#pragma unroll
            for (int kq = 0; kq < 4; ++kq) {
                bf16x8 qa[4];
#pragma unroll
                for (int m = 0; m < 4; ++m) qa[m] = *(const LAS bf16x8*)(qrow + 16 * m * QP + (k4 + kq) * 32);
#pragma unroll
                for (int m = 0; m < 4; ++m)
#pragma unroll
                    for (int n = 0; n < 4; ++n) acc[m][n] = __builtin_amdgcn_mfma_f32_16x16x32_bf16(sb[kq][n], qa[m], acc[m][n], 0, 0, 0);
            }
        }
    }
    LDS_WAIT(); __syncthreads();
    {
        const bf16* vrow = P.VT + (size_t)(h * DV + 64 * wid + fr) * MP + t0 + 8 * fq;
        bf16x8 vb[2][4];
#pragma unroll
        for (int kq = 0; kq < 2; ++kq)
#pragma unroll
            for (int n = 0; n < 4; ++n) vb[kq][n] = *(const bf16x8*)(vrow + (size_t)(16 * n) * MP + kq * 32);
#pragma unroll
        for (int kq = 0; kq < 2; ++kq) {
            bf16x8 pa[4];
#pragma unroll
            for (int m = 0; m < 4; ++m) pa[m] = *(const LAS bf16x8*)(attn + (16 * m + fr) * 72 + kq * 32 + 8 * fq);
#pragma unroll
            for (int m = 0; m < 4; ++m)
#pragma unroll
                for (int n = 0; n < 4; ++n) acc[m][n] = __builtin_amdgcn_mfma_f32_16x16x32_bf16(vb[kq][n], pa[m], acc[m][n], 0, 0, 0);
        }
    }
#pragma unroll
    for (int m = 0; m < 4; ++m) { float sq = 0.f;
#pragma unroll
        for (int n = 0; n < 4; ++n) sq += (acc[m][n][0] * acc[m][n][0] + acc[m][n][1] * acc[m][n][1]) + (acc[m][n][2] * acc[m][n][2] + acc[m][n][3] * acc[m][n][3]);
        sq += __shfl_xor(sq, 16); sq += __shfl_xor(sq, 32);
        if (fq == 0) ssq[(16 * m + fr) * 8 + wid] = sq; }
    LDS_WAIT(); __syncthreads();
#pragma unroll
    for (int m = 0; m < 4; ++m) {
        const LAS float* sp = ssq + (16 * m + fr) * 8;
        const float tot = ((sp[0] + sp[1]) + (sp[2] + sp[3])) + ((sp[4] + sp[5]) + (sp[6] + sp[7]));
        const float rstd = 1.0f / sqrtf(tot * (1.0f / DV) + RMS_EPS);
        const size_t ro = (size_t)(t0 + 16 * m + fr) * D + h * DV + 64 * wid + 4 * fq;
#pragma unroll
        for (int n = 0; n < 4; ++n) {
            const f32x4 nw = *(const f32x4*)(P.norm_w + (size_t)j * DV + 64 * wid + 16 * n + 4 * fq);
            const float og[4] = {__uint_as_float(ogb[m][n].x << 16), __uint_as_float(ogb[m][n].x & 0xffff0000u), __uint_as_float(ogb[m][n].y << 16), __uint_as_float(ogb[m][n].y & 0xffff0000u)};
            float y[4];
#pragma unroll
            for (int e = 0; e < 4; ++e) y[e] = acc[m][n][e] * rstd * nw[e] * (og[e] / (1.0f + __expf(-og[e])));
            v2u w; w.x = cvt_pk_bf16(y[0], y[1]); w.y = cvt_pk_bf16(y[2], y[3]);
            *(v2u*)(P.OB + ro + 16 * n) = w; }
    }
    __syncthreads();
}

__global__ void __launch_bounds__(NWAVES * 64, 2) mk_fwd(Args args) {
    extern __shared__ __attribute__((aligned(16))) unsigned char lds_raw[];
    LAS unsigned char* lds = (LAS unsigned char*)lds_raw;
    const int G0 = gridDim.x, bid0 = blockIdx.x;
    Ctx C; C.ws = args.ws; C.out = args.out; C.sgla = args.in[3];
    const int lo = args.ph_lo, hi = args.ph_hi;
#define IN(k) (lo <= (k) && (k) < hi)
#if MK_N_LAUNCHES == 1
    volatile LAS unsigned* MISC = (volatile LAS unsigned*)(lds + MISC_OFF);
    if (threadIdx.x < 64) MISC[threadIdx.x] = 0u;
    __syncthreads();
    XcdBarrier bar = xcd_barrier_post((unsigned*)(args.ws + WS_CTL) + CW_BAR, MISC + 8);
#define SEAM(k) do { if (IN(k) && IN((k) + 1)) { XcdBarrier b2 = bar; asm volatile("" : "+s"(b2.bar), "+s"(b2.x)); xcd_barrier(b2); } } while (0)
#else
#define SEAM(k) do { } while (0)
#endif
#define PH_IDS const int tid = fresh_tid(), lane = tid & 63, wave = __builtin_amdgcn_readfirstlane(tid >> 6); (void)lane; (void)wave; int bid = bid0, G = G0; asm volatile("" : "+s"(bid), "+s"(G)); const Ptrs P = make_ptrs(C)
#define PH_GW const int gw = bid * NWAVES + wave, NGW = G * NWAVES

    if (IN(0)) { for (int rp = 0; rp < RP_PRO; ++rp) prologue_phase(args, lds, bid0, G0); }
    SEAM(0);

    for (int layer = 0; layer < 4; ++layer) {
        const int jj = layer >> 1;
        const int pb = 1 + jj * 15 + (layer & 1) * 6;
        int pm;
        if ((layer & 1) == 0) {
            if (IN(pb)) { PH_IDS; for (int rp = 0; rp < RP_POOL; ++rp) pool_prep_phase(P, jj, bid, G, tid); }
            SEAM(pb);
            if (IN(pb + 1)) { PH_IDS;
                pg8::Gemm g{P.PB, P.WP + (size_t)jj * 4 * 512 * 512};
                pg8::StaticOrder<MP, D> S; S.init(G, bid);
                pg8::EpiBf16<0> E{P.YB, D, nullptr, 0, 0};
                for (int rp = 0; rp < RP_POOL; ++rp) pg8::gemm_phase<pg8::EpiBf16<0>, pg8::StaticOrder<MP, D>, true, D, 512, 512, 1, 1024>(lds, g, S, E);
                for (int uu = bid; uu < RP_MICRO * (64); uu += G) { const int u = uu % (64);
                    const int gidx = u >> 4, ct = u & 15;
                    float* slab = P.SLAB + gidx * 512 + ct * 32;
                    micro_unit<2, D, 512, 512>(P.PB + (size_t)MP * D + gidx * 512, P.WP + ((size_t)(jj * 4 + gidx) * 512 + ct * 32) * 512, lds, tid, wave, lane,
                        [=](int r, int cc, const f32x4& v) { *(f32x4*)(slab + (size_t)r * D + cc) = v; });
                }
            }
            SEAM(pb + 1);
            if (IN(pb + 2)) { PH_IDS; PH_GW; ln_phase(P, 1, nullptr, P.pool_scale + (size_t)jj * D, P.ln_mix_g + (size_t)layer * D, P.ln_mix_b + (size_t)layer * D, false, gw, NGW, lane); }
            SEAM(pb + 2);
            pm = pb + 3;
        } else {
            if (IN(pb)) { PH_IDS;
                const bf16* win = P.WIN + (size_t)jj * WIN_LAYER;
                {
                    pg8::Gemm g{P.XB, win};
                    pg8::StaticOrder<MP, 4096> S; S.init(G, bid);
                    pg8::EpiBf16<0> E{P.QK, D, nullptr, 2048, (size_t)(WS_OG - WS_QK) / 2};
                    for (int rp = 0; rp < RP_GLAGEMM; ++rp) pg8::gemm_phase<pg8::EpiBf16<0>, pg8::StaticOrder<MP, 4096>, true, D, D, D>(lds, g, S, E);
                }
                {
                    pg8::Gemm g{win + (size_t)4096 * D, P.XB};
                    pg8::StaticOrder<2048, MP> S; S.init(G, bid);
                    pg8::EpiBf16<0> E{P.VT, MP, nullptr, 0, 0};
                    for (int rp = 0; rp < RP_GLAGEMM; ++rp) pg8::gemm_phase<pg8::EpiBf16<0>, pg8::StaticOrder<2048, MP>, true, D, D, D>(lds, g, S, E);
                }
                for (int uu = bid; uu < RP_MICRO * 192; uu += G) { const int u = uu % 192;
                    float* o = P.SQKV + u * 32;
                    micro_unit<2, D, D, D>(P.XB + (size_t)MP * D, win + (size_t)u * 32 * D, lds, tid, wave, lane,
                        [=](int r, int cc, const f32x4& v) { *(f32x4*)(o + (size_t)r * 6144 + cc) = v; });
                }
                for (int uu = bid; uu < RP_MICRO * 65; uu += G) { const int rb = uu % 65;
                    float* o = P.GKL + (size_t)rb * 128 * NRANK;
                    micro_unit<1, D, D, D>(P.XB + (size_t)rb * 128 * D, win + (size_t)6144 * D, lds, tid, wave, lane,
                        [=](int r, int cc, const f32x4& v) { *(f32x4*)(o + (size_t)r * NRANK + cc) = v; });
                }
            }
            SEAM(pb);
            if (IN(pb + 1)) { PH_IDS;
                for (int rp = 0; rp < RP_PREP; ++rp) for (int it = bid; it < 512; it += G) gla_prep_item(P, jj, it, lds, tid);
                for (int rp = 0; rp < RP_DEC; ++rp) for (int it = bid; it < 512; it += G) gla_decode_item(P, jj, it, lds, tid);
            }
            SEAM(pb + 1);
            if (IN(pb + 2)) { PH_IDS; for (int rp = 0; rp < RP_SCAN; ++rp) for (int u = bid; u < 256; u += G) gla_scan_item(P, jj, u, wave, lane); }
            SEAM(pb + 2);
            if (IN(pb + 3)) { PH_IDS; for (int rp = 0; rp < RP_GOUT; ++rp) for (int it = bid; it < 512; it += G) gla_out_item(P, jj, it, lds, tid, wave, lane); }
            SEAM(pb + 3);
            if (IN(pb + 4)) { PH_IDS;
                pg8::Gemm g{P.OB, P.WOUT + (size_t)jj * D * D};
                pg8::StaticOrder<MP, D> S; S.init(G, bid);
                pg8::EpiBf16<0> E{P.YB, D, nullptr, 0, 0};
                for (int rp = 0; rp < RP_GLAGEMM; ++rp) pg8::gemm_phase<pg8::EpiBf16<0>, pg8::StaticOrder<MP, D>, true, D, D, D>(lds, g, S, E);
                for (int uu = bid; uu < RP_MICRO * (256); uu += G) { const int u = uu % (256);
                    const int ct = u & 63, ks = u >> 6;
                    float* slab = P.SLAB + (size_t)ks * MS * D + ct * 32;
                    micro_unit<2, D, D, 512>(P.OB + (size_t)MP * D + ks * 512, P.WOUT + (size_t)jj * D * D + (size_t)ct * 32 * D + ks * 512, lds, tid, wave, lane,
                        [=](int r, int cc, const f32x4& v) { *(f32x4*)(slab + (size_t)r * D + cc) = v; });
                }
            }
            SEAM(pb + 4);
            if (IN(pb + 5)) { PH_IDS; PH_GW; ln_phase(P, 4, nullptr, nullptr, P.ln_mix_g + (size_t)layer * D, P.ln_mix_b + (size_t)layer * D, false, gw, NGW, lane); }
            SEAM(pb + 5);
            pm = pb + 6;
        }
        if (IN(pm)) { PH_IDS;
            const bf16* w1 = P.W1 + (size_t)layer * D * DFF; const float* b1 = P.b1 + (size_t)layer * DFF;
            pg8::Gemm g{P.XB, w1};
            pg8::StaticOrder<MP, DFF> S; S.init(G, bid);
            pg8::EpiBf16<1> E{P.HB, DFF, b1, 0, 0};
            for (int rp = 0; rp < RP_MLP; ++rp) pg8::gemm_phase<pg8::EpiBf16<1>, pg8::StaticOrder<MP, DFF>, true, D, D, D>(lds, g, S, E);
            for (int uu = bid; uu < RP_MICRO * (256); uu += G) { const int u = uu % (256);
                bf16* o = P.HB + (size_t)MP * DFF + u * 32; const float* bb = b1 + u * 32;
                micro_unit<2, D, D, D>(P.XB + (size_t)MP * D, w1 + (size_t)u * 32 * D, lds, tid, wave, lane,
                    [=](int r, int cc, const f32x4& v) { const f32x4 bv = *(const f32x4*)(bb + cc); float y[4];
#pragma unroll
                        for (int e = 0; e < 4; ++e) { const float a = fmaxf(v[e] + bv[e], 0.f); y[e] = a * a; }
                        v2u w; w.x = cvt_pk_bf16(y[0], y[1]); w.y = cvt_pk_bf16(y[2], y[3]); *(v2u*)(o + (size_t)r * DFF + cc) = w; });
            }
        }
        SEAM(pm);
        if (IN(pm + 1)) { PH_IDS;
            const bf16* w2 = P.W2 + (size_t)layer * DFF * D;
            pg8::Gemm g{P.HB, w2};
            pg8::StaticOrder<MP, D> S; S.init(G, bid);
            pg8::EpiBf16<0> E{P.YB, D, nullptr, 0, 0};
            for (int rp = 0; rp < RP_MLP; ++rp) pg8::gemm_phase<pg8::EpiBf16<0>, pg8::StaticOrder<MP, D>, true, DFF, DFF, DFF>(lds, g, S, E);
            for (int uu = bid; uu < RP_MICRO * (256); uu += G) { const int u = uu % (256);
                const int ct = u & 63, ks = u >> 6;
                float* slab = P.SLAB + (size_t)ks * MS * D + ct * 32;
                micro_unit<2, DFF, DFF, 2048>(P.HB + (size_t)MP * DFF + ks * 2048, w2 + (size_t)ct * 32 * DFF + ks * 2048, lds, tid, wave, lane,
                    [=](int r, int cc, const f32x4& v) { *(f32x4*)(slab + (size_t)r * D + cc) = v; });
            }
        }
        SEAM(pm + 1);
        if (IN(pm + 2)) { PH_IDS; PH_GW; ln_phase(P, 4, P.b2 + (size_t)layer * D, nullptr, P.ln_ffn_g + (size_t)layer * D, P.ln_ffn_b + (size_t)layer * D, layer == 3, gw, NGW, lane); }
        if (layer < 3) SEAM(pm + 2);
    }
#undef IN
#undef SEAM
}

extern "C" void kernel_launch(void* const* d_in, const int* in_sizes, int n_in, void* d_out, int out_size, void* d_ws, size_t ws_size, hipStream_t stream) {
    static int grid = 0;
    if (grid == 0) {
        if (n_in != 19 || (size_t)out_size != O_END || ws_size < WS_END) { fprintf(stderr, "kernel_launch: unexpected shapes: n_in %d out %d ws %zu\n", n_in, out_size, ws_size); grid = -1; return; }
        int dev = 0, cus = 0, per_cu = 0;
        if (hipGetDevice(&dev) != hipSuccess || hipDeviceGetAttribute(&cus, hipDeviceAttributeMultiprocessorCount, dev) != hipSuccess) { grid = -1; return; }
        if (hipFuncSetAttribute((const void*)mk_fwd, hipFuncAttributeMaxDynamicSharedMemorySize, LDS_BYTES) != hipSuccess) { fprintf(stderr, "kernel_launch: hipFuncSetAttribute failed\n"); grid = -1; return; }
        if (hipOccupancyMaxActiveBlocksPerMultiprocessor(&per_cu, (const void*)mk_fwd, NWAVES * 64, LDS_BYTES) != hipSuccess || per_cu < 1)
            fprintf(stderr, "kernel_launch: occupancy query reports %d workgroups per CU\n", per_cu);
        (void)hipGetLastError();
        grid = cus;
    }
    if (grid < 0) return;
    if (hipMemsetAsync((char*)d_ws + WS_CTL, 0, CTL_ZERO_BYTES, stream) != hipSuccess) return;
    Args a{};
    for (int i = 0; i < 19; ++i) a.in[i] = (const float*)d_in[i];
    a.out = (float*)d_out; a.ws = (unsigned char*)d_ws;
    if (MK_N_LAUNCHES == 1) {
        a.ph_lo = 0; a.ph_hi = NPHASE;
        hipLaunchKernelGGL(mk_fwd, dim3(grid), dim3(NWAVES * 64), LDS_BYTES, stream, a);
    } else {
        for (int p = 0; p < NPHASE; ++p) { a.ph_lo = p; a.ph_hi = p + 1;
            hipLaunchKernelGGL(mk_fwd, dim3(grid), dim3(NWAVES * 64), LDS_BYTES, stream, a); }
    }
}
```
